# Optimizing an MI355X kernel written in HIP

```python
import math
import jax
import jax.numpy as jnp
from jax import lax
import numpy as np

D_MODEL = 1024
BATCH = 4
SEQ = 4096
DEPTH = 1

CTX_LEN = 256
GRID_W = 64
NORM_EPS = 1e-6
A_GROUPS = 8
A_WIDTH = 1024
A_GW = A_WIDTH // A_GROUPS
A_CHUNK = 128
B_HEADS = 8
B_HEAD_DIM = 128
B_WIDTH = B_HEADS * B_HEAD_DIM
B_CHUNK = 64
SHORT_CONV = 3
D_FF = 2816
FFN_CONV = 3
OFF_K = 0
OFF_V = OFF_K + B_WIDTH
OFF_BA = OFF_V + B_WIDTH
OFF_Q = OFF_BA + 4 * B_HEADS
OFF_Z = OFF_Q + B_WIDTH
OFF_U = OFF_Z + B_WIDTH
OFF_AV = OFF_U + A_WIDTH
OFF_GA = OFF_AV + A_WIDTH
OFF_GB = OFF_GA + D_MODEL
IN_COLS = OFF_GB + D_MODEL
STATE_COLS = OFF_Q

kernel_name = 'hybrid_gmlp_gdn_dit_block'


def rms_norm(x, g):
    xf = x.astype(jnp.float32)
    y = xf * lax.rsqrt(jnp.mean(xf * xf, axis=-1, keepdims=True) + NORM_EPS)
    return (y * g.astype(jnp.float32)).astype(x.dtype)


def layer_norm(x, g, b):
    xf = x.astype(jnp.float32)
    mu = jnp.mean(xf, axis=-1, keepdims=True)
    xc = xf - mu
    y = xc * lax.rsqrt(jnp.mean(xc * xc, axis=-1, keepdims=True) + NORM_EPS)
    return (y * g.astype(jnp.float32) + b.astype(jnp.float32)).astype(x.dtype)


def l2norm(t):
    return t * lax.rsqrt(jnp.sum(t * t, axis=-1, keepdims=True) + NORM_EPS)


def modulate(h, shift, scale):
    return h * (1.0 + scale) + shift


def to_heads(t):
    bsz, length, _ = t.shape
    return t.reshape(bsz, length, B_HEADS, B_HEAD_DIM).transpose(0, 2, 1, 3)


def from_heads(t):
    bsz, nh, length, hd = t.shape
    return t.transpose(0, 2, 1, 3).reshape(bsz, length, nh * hd)


def dwconv(x, w, n_rows):
    bsz, length, ch = x.shape
    row_len = length // n_rows
    taps = w.shape[0]
    pad = taps // 2
    xp = jnp.pad(x.reshape(bsz, n_rows, row_len, ch), ((0, 0), (0, 0), (pad, pad), (0, 0)))
    y = xp[:, :, 0:row_len] * w[0]
    for t in range(1, taps):
        y = y + xp[:, :, t:t + row_len] * w[t]
    return y.reshape(bsz, length, ch)


def gated_delta_chunked(q, k, v, beta, g, s0):
    bsz, nh, length, _ = k.shape
    dv = v.shape[-1]
    n = length // B_CHUNK

    def chunks(t):
        return jnp.moveaxis(t.reshape(bsz, nh, n, B_CHUNK, *t.shape[3:]), 2, 0)

    k, v, beta, g = chunks(k), chunks(v), chunks(beta), chunks(g)
    gc = jnp.cumsum(g, axis=-1)
    pos = jnp.arange(B_CHUNK)
    incl = pos[:, None] >= pos[None, :]
    strict = pos[:, None] > pos[None, :]
    diff = gc[..., :, None] - gc[..., None, :]
    gamma = jnp.where(incl, jnp.exp(jnp.where(incl, diff, 0.0)), 0.0)
    kb = k * beta[..., None]
    m = jnp.where(strict, jnp.einsum('nbhid,nbhjd->nbhij', kb, k) * gamma, 0.0)
    eye = jnp.eye(B_CHUNK, dtype=k.dtype)
    t_inv = lax.linalg.triangular_solve(eye + m, jnp.broadcast_to(eye, m.shape), left_side=True, lower=True)
    w_c = t_inv @ (kb * jnp.exp(gc)[..., None])
    u_c = t_inv @ (v * beta[..., None])
    g_end = gc[..., -1]
    kd = k * jnp.exp(g_end[..., None] - gc)[..., None]

    def update(s, w_i, u_i, kd_i, ge_i):
        v_new = u_i - jnp.einsum('bhck,bhkv->bhcv', w_i, s)
        s_next = s * jnp.exp(ge_i)[..., None, None] + jnp.einsum('bhck,bhcv->bhkv', kd_i, v_new)
        return v_new, s_next

    if q is None:
        def step_state(s, xs):
            _, s_next = update(s, *xs)
            return s_next, None
        s_fin, _ = lax.scan(step_state, s0, (w_c, u_c, kd, g_end))
        return None, s_fin

    q = chunks(q)
    qk = jnp.einsum('nbhid,nbhjd->nbhij', q, k) * gamma
    qg = q * jnp.exp(gc)[..., None]

    def step(s, xs):
        w_i, u_i, kd_i, ge_i, qg_i, qk_i = xs
        v_new, s_next = update(s, w_i, u_i, kd_i, ge_i)
        o = jnp.einsum('bhck,bhkv->bhcv', qg_i, s) + jnp.einsum('bhij,bhjv->bhiv', qk_i, v_new)
        return s_next, o

    s_fin, o = lax.scan(step, s0, (w_c, u_c, kd, g_end, qg, qk))
    o = jnp.moveaxis(o, 0, 2).reshape(bsz, nh, length, dv)
    return o, s_fin


def delta_prep(p, conv_w, a_log, dt_bias, with_q):
    f32 = jnp.float32
    bsz, length = p.shape[0], p.shape[1]
    kv = jax.nn.silu(dwconv(p[..., OFF_K:OFF_BA], conv_w[:, :2 * B_WIDTH], 1)).astype(f32)
    k = l2norm(to_heads(kv[..., :B_WIDTH]))
    v = to_heads(kv[..., B_WIDTH:])
    ba = p[..., OFF_BA:OFF_Q].astype(f32).reshape(bsz, length, 4, B_HEADS).transpose(2, 0, 3, 1)
    beta = jax.nn.sigmoid(ba[:2])
    g = -jnp.exp(a_log.astype(f32))[:, None, :, None] * jax.nn.softplus(
        ba[2:] + dt_bias.astype(f32)[:, None, :, None])
    q = None
    if with_q:
        qr = jax.nn.silu(dwconv(p[..., OFF_Q:OFF_Z], conv_w[:, 2 * B_WIDTH:], 1)).astype(f32)
        q = l2norm(to_heads(qr)) * (B_HEAD_DIM ** -0.5)
    return q, k, v, beta, g


def flip_seq(t):
    return jnp.flip(t, axis=2)


def bidir_delta(q, k, v, beta, g, s0):
    o_f, s_f = gated_delta_chunked(q, k, v, beta[0], g[0], s0[0])
    o_b, s_b = gated_delta_chunked(flip_seq(q), flip_seq(k), flip_seq(v), flip_seq(beta[1]),
                                   flip_seq(g[1]), s0[1])
    return o_f + flip_seq(o_b), jnp.stack([s_f, s_b])


def bidir_delta_state(k, v, beta, g):
    bsz = k.shape[0]
    zero = jnp.zeros((bsz, B_HEADS, B_HEAD_DIM, B_HEAD_DIM), jnp.float32)
    _, s_f = gated_delta_chunked(None, k, v, beta[0], g[0], zero)
    _, s_b = gated_delta_chunked(None, flip_seq(k), flip_seq(v), flip_seq(beta[1]), flip_seq(g[1]), zero)
    return jnp.stack([s_f, s_b])


def chunk_mlp(u, v, ln_g, ln_b, w_s, b_s):
    bsz, length, _ = u.shape
    v = layer_norm(v, ln_g, ln_b)
    vc = v.reshape(bsz, length // A_CHUNK, A_CHUNK, A_GROUPS, A_GW)
    s = jnp.einsum('gij,bnjgc->bnigc', w_s, vc) + b_s.T[None, None, :, :, None]
    return u * s.reshape(bsz, length, A_WIDTH)


def token_mixers(h, s0, w_in, conv_qkv, a_log, dt_bias, onorm_g, w_proj_b,
                 a_ln_g, a_ln_b, a_ws, a_bs, w_proj_a, w_out):
    p = h @ w_in
    q, k, v, beta, g = delta_prep(p, conv_qkv, a_log, dt_bias, True)
    o, states = bidir_delta(q, k, v, beta, g, s0)
    z = to_heads(p[..., OFF_Z:OFF_U]).astype(jnp.float32)
    o = rms_norm(o, onorm_g) * jax.nn.silu(z)
    y_b = from_heads(o).astype(h.dtype) @ w_proj_b
    u = jax.nn.gelu(p[..., OFF_U:OFF_AV])
    va = jax.nn.gelu(p[..., OFF_AV:OFF_GA])
    y_a = chunk_mlp(u, va, a_ln_g, a_ln_b, a_ws, a_bs) @ w_proj_a
    g_a = jax.nn.sigmoid(p[..., OFF_GA:OFF_GB])
    g_b = jax.nn.sigmoid(p[..., OFF_GB:IN_COLS])
    return (g_a * y_a + g_b * y_b) @ w_out, states


def conv_ffn(h, n_rows, w_up, conv_w, conv_b, w_down):
    a, b = jnp.split(h @ w_up, 2, axis=-1)
    a = dwconv(a, conv_w, n_rows) + conv_b
    return (jax.nn.gelu(a) * b) @ w_down


def setup_inputs(seed: int = 0) -> dict:
    key = jax.random.key(seed)
    ks = iter(jax.random.split(key, 32))
    f32 = jnp.float32

    def nrm(shape, scale):
        return jax.random.normal(next(ks), shape, f32) * scale

    def gain(shape):
        return 1.0 + 0.02 * jax.random.normal(next(ks), shape, f32)

    x = nrm((BATCH, SEQ, D_MODEL), 1.0)
    c = nrm((BATCH, D_MODEL), 1.0)
    ctx = nrm((BATCH, CTX_LEN, D_MODEL), 1.0)
    c_ctx = nrm((D_MODEL,), 1.0)
    w_mod = nrm((DEPTH, D_MODEL, 6 * D_MODEL), 0.5 * D_MODEL ** -0.5)
    b_mod = nrm((DEPTH, 6 * D_MODEL), 0.02)
    norm1_g = gain((DEPTH, D_MODEL))
    w_in = nrm((DEPTH, D_MODEL, IN_COLS), D_MODEL ** -0.5)
    conv_qkv = nrm((DEPTH, SHORT_CONV, 3 * B_WIDTH), SHORT_CONV ** -0.5)
    a_log = jnp.log(jax.random.uniform(next(ks), (DEPTH, 2, B_HEADS), f32, 1.0, 16.0))
    dt = jnp.exp(jax.random.uniform(next(ks), (DEPTH, 2, B_HEADS), f32, math.log(1e-3), math.log(1e-1)))
    dt_bias = dt + jnp.log(-jnp.expm1(-dt))
    onorm_g = gain((DEPTH, B_HEAD_DIM))
    w_proj_b = nrm((DEPTH, B_WIDTH, D_MODEL), B_WIDTH ** -0.5)
    a_ln_g = gain((DEPTH, A_WIDTH))
    a_ln_b = nrm((DEPTH, A_WIDTH), 0.02)
    a_ws = nrm((DEPTH, A_GROUPS, A_CHUNK, A_CHUNK), A_CHUNK ** -0.5)
    a_bs = 1.0 + nrm((DEPTH, A_GROUPS, A_CHUNK), 0.02)
    w_proj_a = nrm((DEPTH, A_WIDTH, D_MODEL), A_WIDTH ** -0.5)
    w_out = nrm((DEPTH, D_MODEL, D_MODEL), D_MODEL ** -0.5)
    norm2_g = gain((DEPTH, D_MODEL))
    w_up = nrm((DEPTH, D_MODEL, 2 * D_FF), D_MODEL ** -0.5)
    ffn_conv_w = nrm((DEPTH, FFN_CONV, D_FF), FFN_CONV ** -0.5)
    ffn_conv_b = nrm((DEPTH, D_FF), 0.02)
    w_down = nrm((DEPTH, D_FF, D_MODEL), D_FF ** -0.5)
    final_g = gain((D_MODEL,))
    return {'x': x, 'c': c, 'ctx': ctx, 'c_ctx': c_ctx, 'w_mod': w_mod, 'b_mod': b_mod,
            'norm1_g': norm1_g, 'w_in': w_in, 'conv_qkv': conv_qkv, 'a_log': a_log,
            'dt_bias': dt_bias, 'onorm_g': onorm_g, 'w_proj_b': w_proj_b, 'a_ln_g': a_ln_g,
            'a_ln_b': a_ln_b, 'a_ws': a_ws, 'a_bs': a_bs, 'w_proj_a': w_proj_a, 'w_out': w_out,
            'norm2_g': norm2_g, 'w_up': w_up, 'ffn_conv_w': ffn_conv_w, 'ffn_conv_b': ffn_conv_b,
            'w_down': w_down, 'final_g': final_g}


def reference(x, c, ctx, c_ctx, w_mod, b_mod, norm1_g, w_in, conv_qkv, a_log, dt_bias, onorm_g,
              w_proj_b, a_ln_g, a_ln_b, a_ws, a_bs, w_proj_a, w_out, norm2_g, w_up, ffn_conv_w,
              ffn_conv_b, w_down, final_g):
    rows = x.shape[1] // GRID_W
    cond = jax.nn.silu(c)
    cond_ctx = jax.nn.silu(c_ctx)
    for l in range(DEPTH):
        last = l == DEPTH - 1
        mod = (cond @ w_mod[l] + b_mod[l])[:, None, :]
        mod_c = cond_ctx @ w_mod[l] + b_mod[l]
        sh1, sc1, gt1, sh2, sc2, gt2 = jnp.split(mod, 6, axis=-1)
        csh1, csc1, cgt1, csh2, csc2, cgt2 = jnp.split(mod_c, 6, axis=-1)
        mix_w = (conv_qkv[l], a_log[l], dt_bias[l], onorm_g[l], w_proj_b[l], a_ln_g[l], a_ln_b[l],
                 a_ws[l], a_bs[l], w_proj_a[l], w_out[l])
        hc = modulate(rms_norm(ctx, norm1_g[l]), csh1, csc1)
        if last:
            pc = hc @ w_in[l][:, :STATE_COLS]
            _, kc, vc, betac, gcx = delta_prep(pc, conv_qkv[l], a_log[l], dt_bias[l], False)
            s_ctx = bidir_delta_state(kc, vc, betac, gcx)
        else:
            zero = jnp.zeros((2, ctx.shape[0], B_HEADS, B_HEAD_DIM, B_HEAD_DIM), jnp.float32)
            yc, s_ctx = token_mixers(hc, zero, w_in[l], *mix_w)
        hx = modulate(rms_norm(x, norm1_g[l]), sh1, sc1)
        y, _ = token_mixers(hx, s_ctx, w_in[l], *mix_w)
        x = x + gt1 * y
        hx2 = modulate(rms_norm(x, norm2_g[l]), sh2, sc2)
        x = x + gt2 * conv_ffn(hx2, rows, w_up[l], ffn_conv_w[l], ffn_conv_b[l], w_down[l])
        if not last:
            ctx = ctx + cgt1 * yc
            hc2 = modulate(rms_norm(ctx, norm2_g[l]), csh2, csc2)
            ctx = ctx + cgt2 * conv_ffn(hc2, 1, w_up[l], ffn_conv_w[l], ffn_conv_b[l], w_down[l])
    return rms_norm(x, final_g)
```

```cpp
#include <hip/hip_runtime.h>
#include <hip/hip_cooperative_groups.h>
#include <cstdio>
#include <cstdint>
namespace cg = cooperative_groups;
namespace pg8 {
#define PG8_LAS __attribute__((address_space(3)))
typedef unsigned short bf16_t;
typedef short bf16x8 __attribute__((ext_vector_type(8)));
typedef float f32x4 __attribute__((ext_vector_type(4)));
typedef unsigned u32x4 __attribute__((ext_vector_type(4)));
constexpr int BM = 256, BK = 64, HALF = 128, HTB = HALF * BK * 2  , STAGE_BYTES = 8 * HTB, NXCD = 8, WGM = 8;

__host__ __device__ __forceinline__ int lds_byte(int r, int c) { const int st = (r >> 4) * 2 + (c >> 5), rr = r & 15, cc = c & 31, ob = rr * 64 + cc * 2; return st * 1024 + (ob ^ (((ob >> 9) & 1) << 5)); }
__host__ __device__ __forceinline__ void stage_rc(int b, int& R, int& C) { const int st = b / 1024, sb = b % 1024, swz = sb ^ (((sb >> 9) & 1) << 5); R = (st >> 1) * 16 + swz / 64; C = (st & 1) * 32 + (swz % 64) / 2; }
__host__ __device__ __forceinline__ int perm32(int rho) { const int n = rho >> 4, i = rho & 15; return 8 * (i >> 2) + 4 * n + (i & 3); }

struct Unit { int pm, pn; };
struct Gemm { const bf16_t* A; const bf16_t* Bt; int M, N, K; };

struct StaticOrder {
    int nM, nN, nwg, G, c;
    __host__ __device__ void init(int M, int N, int G_, int c_) { nM = M / BM; nN = N / BM; nwg = nM * nN; G = G_; c = c_; }
    __host__ __device__ bool next(int i, Unit& u) const {
        const long L = (long)i * G + c; if (L >= nwg) return false;
        int wgid = (int)L; { const int q = nwg / NXCD, r = nwg % NXCD, xcd = wgid % NXCD, off = wgid / NXCD; wgid = (xcd < r ? xcd * (q + 1) : r * (q + 1) + (xcd - r) * q) + off; }
        const int nig = WGM * nN, gid = wgid / nig, fm = gid * WGM, gsz = (nM - fm) < WGM ? (nM - fm) : WGM;
        u.pm = fm + ((wgid % nig) % gsz); u.pn = (wgid % nig) / gsz; return true;
    }
    __device__ __forceinline__ void a_ready(const Unit&) const {}
    __device__ __forceinline__ void done(const Unit&) const {}
};
__device__ __forceinline__ unsigned cvt_pk_bf16(float lo, float hi) { unsigned r; asm volatile("v_cvt_pk_bf16_f32 %0, %1, %2" : "=v"(r) : "v"(lo), "v"(hi)); return r; }
template <class Epi, class Sched, bool STAMP = false>
__device__ __forceinline__ void gemm_phase(PG8_LAS unsigned char* lds, const Gemm g, const Sched& S, const Epi& E, unsigned long long* stamps) {
    const int tid = threadIdx.x, wid = __builtin_amdgcn_readfirstlane(tid >> 6), lane = tid & 63, wr = wid >> 2, wc = wid & 3, fr = lane & 15, fq = lane >> 4;
    const int K = g.K, nt = K / BK;
    int ts_lo = 0, ts_hi = 0, nts = 0; const unsigned long long rt_entry = STAMP ? (unsigned long long)wall_clock64() : 0ull;
#define PG8_STAMP() do { if (STAMP && wid == 0 && nts < 64) { const unsigned long long _c = (unsigned long long)clock64(); \
        ts_lo = (lane == nts) ? (int)(unsigned)_c : ts_lo; ts_hi = (lane == nts) ? (int)(unsigned)(_c >> 32) : ts_hi; ++nts; } } while (0)
    PG8_STAMP();
    unsigned voffA[2], voffB[2];
#pragma unroll
    for (int i = 0; i < 2; ++i) { int R, C; stage_rc(tid * 16 + i * 8192, R, C); const int Rb = Epi::PERM ? ((R & ~31) + perm32(R & 31)) : R;
        voffA[i] = (unsigned)(R * K + C) * 2u; voffB[i] = (unsigned)(Rb * K + C) * 2u; }
    const size_t kstep = (size_t)(BK * 2);
    const size_t hstep = (size_t)HALF * K * 2;
    const size_t tstep = 2 * hstep;
    const unsigned ldsw = (unsigned)wid * 1024u;
    const int aoff = lds_byte(wr * 64 + fr, fq * 8), boff = lds_byte(wc * 32 + fr, fq * 8);
#define PG8_SA(b, h) (((b) * 2 + (h)) * HTB)
#define PG8_SB(b, h) ((4 + (b) * 2 + (h)) * HTB)
#define PG8_STAGE(bufoff, gbase, voff) do { _Pragma("unroll") for (int _i = 0; _i < 2; ++_i) \
        __builtin_amdgcn_global_load_lds((const unsigned*)((const char*)(gbase) + (voff)[_i]), (PG8_LAS unsigned*)(lds + (bufoff) + ldsw + _i * 8192), 16, 0, 0); } while (0)
#define PG8_LDA(dst, b, h) do { _Pragma("unroll") for (int m = 0; m < 4; ++m) _Pragma("unroll") for (int k = 0; k < 2; ++k) dst[m][k] = *(const PG8_LAS bf16x8*)(lds + PG8_SA(b, h) + aoff + m * 2048 + k * 1024); } while (0)
#define PG8_LDB(dst, b, h) do { _Pragma("unroll") for (int n = 0; n < 2; ++n) _Pragma("unroll") for (int k = 0; k < 2; ++k) dst[n][k] = *(const PG8_LAS bf16x8*)(lds + PG8_SB(b, h) + boff + n * 2048 + k * 1024); } while (0)
#define PG8_MMA(ai, bj, At, Bt) do { __builtin_amdgcn_s_setprio(1); _Pragma("unroll") for (int m = 0; m < 4; ++m) _Pragma("unroll") for (int n = 0; n < 2; ++n) _Pragma("unroll") for (int k = 0; k < 2; ++k) \
        acc[ai][bj][m][n] = __builtin_amdgcn_mfma_f32_16x16x32_bf16(Bt[n][k], At[m][k], acc[ai][bj][m][n], 0, 0, 0); __builtin_amdgcn_s_setprio(0); } while (0)
#define PG8_WAIT_V(n) asm volatile("s_waitcnt vmcnt(" #n ")" ::: "memory")
#define PG8_WAIT_L(n) asm volatile("s_waitcnt lgkmcnt(" #n ")" ::: "memory")
#define PG8_BAR __builtin_amdgcn_s_barrier()
#define PG8_SCHED __builtin_amdgcn_sched_barrier(0)
    Unit cur, nxt; int ui = 0;
    if (!S.next(0, cur)) return;
    f32x4 acc[2][2][4][2];
#pragma unroll
    for (int a = 0; a < 2; ++a)
#pragma unroll
        for (int b = 0; b < 2; ++b)
#pragma unroll
            for (int m = 0; m < 4; ++m)
#pragma unroll
                for (int n = 0; n < 2; ++n) acc[a][b][m][n] = (f32x4){0.f, 0.f, 0.f, 0.f};
    bf16x8 At[4][2], B0[2][2], B1[2][2];
    const char* cA = (const char*)g.A + (size_t)cur.pm * tstep; const char* cB = (const char*)g.Bt + (size_t)cur.pn * tstep;
    S.a_ready(cur);
    PG8_STAGE(PG8_SB(0, 0), cB, voffB); PG8_STAGE(PG8_SA(0, 0), cA, voffA); PG8_STAGE(PG8_SB(0, 1), cB + hstep, voffB); PG8_STAGE(PG8_SA(0, 1), cA + hstep, voffA);
    if (wr == 1) PG8_BAR;
    PG8_WAIT_V(4); PG8_BAR;
    PG8_STAGE(PG8_SB(1, 0), cB + kstep, voffB); PG8_STAGE(PG8_SA(1, 0), cA + kstep, voffA); PG8_STAGE(PG8_SB(1, 1), cB + hstep + kstep, voffB);
    PG8_WAIT_V(6); PG8_BAR;
    PG8_STAMP();
    for (;;) {
        const bool has_next = S.next(ui + 1, nxt);
        const char* nA = has_next ? (const char*)g.A + (size_t)nxt.pm * tstep : cA; const char* nB = has_next ? (const char*)g.Bt + (size_t)nxt.pn * tstep : cB;
        for (int t = 0; t < nt; t += 2) {
            const bool last = (t == nt - 2);
            const char* a1 = cA + (size_t)(t + 1) * kstep;
            const char* a2 = last ? nA : cA + (size_t)(t + 2) * kstep; const char* b2 = last ? nB : cB + (size_t)(t + 2) * kstep;
            const char* a3 = a2 + kstep; const char* b3 = b2 + kstep;
            if (last && has_next) S.a_ready(nxt);
            PG8_LDB(B0, 0, 0); PG8_SCHED; PG8_LDA(At, 0, 0); PG8_STAGE(PG8_SA(1, 1), a1 + hstep, voffA);
            PG8_WAIT_L(8); PG8_BAR; PG8_WAIT_L(0); PG8_MMA(0, 0, At, B0); PG8_BAR; PG8_SCHED;
            PG8_LDB(B1, 0, 1); PG8_STAGE(PG8_SB(0, 0), b2, voffB);
            PG8_BAR; PG8_WAIT_L(0); PG8_MMA(0, 1, At, B1); PG8_BAR;
            PG8_LDA(At, 0, 1); PG8_STAGE(PG8_SA(0, 0), a2, voffA);
            PG8_BAR; PG8_WAIT_L(0); PG8_MMA(1, 0, At, B0); PG8_BAR; PG8_SCHED;
            PG8_STAGE(PG8_SB(0, 1), b2 + hstep, voffB);
            PG8_WAIT_V(6); PG8_BAR; PG8_MMA(1, 1, At, B1); PG8_BAR;
            PG8_LDB(B0, 1, 0); PG8_SCHED; PG8_LDA(At, 1, 0); PG8_STAGE(PG8_SA(0, 1), a2 + hstep, voffA);
            PG8_WAIT_L(8); PG8_BAR; PG8_WAIT_L(0); PG8_MMA(0, 0, At, B0); PG8_BAR; PG8_SCHED;
            PG8_LDB(B1, 1, 1); PG8_STAGE(PG8_SB(1, 0), b3, voffB);
            PG8_BAR; PG8_WAIT_L(0); PG8_MMA(0, 1, At, B1); PG8_BAR;
            PG8_LDA(At, 1, 1); PG8_STAGE(PG8_SA(1, 0), a3, voffA);
            PG8_BAR; PG8_WAIT_L(0); PG8_MMA(1, 0, At, B0); PG8_BAR; PG8_SCHED;
            PG8_STAGE(PG8_SB(1, 1), b3 + hstep, voffB);
            PG8_WAIT_V(6); PG8_BAR; PG8_MMA(1, 1, At, B1); PG8_BAR;
        }
        PG8_STAMP();
        if constexpr (!Epi::AFTER_DRAIN) { E(acc, cur, wr, wc, fr, fq); S.done(cur); }
        PG8_STAMP();
        if (!has_next) break;
#pragma unroll
        for (int a = 0; a < 2; ++a)
#pragma unroll
            for (int b = 0; b < 2; ++b)
#pragma unroll
                for (int m = 0; m < 4; ++m)
#pragma unroll
                    for (int n = 0; n < 2; ++n) acc[a][b][m][n] = (f32x4){0.f, 0.f, 0.f, 0.f};
        cur = nxt; cA = nA; cB = nB; ++ui;
    }
    PG8_WAIT_V(0);
    if (wr == 0) PG8_BAR;
    PG8_BAR;
    if constexpr (Epi::AFTER_DRAIN) { E.fused(acc, cur, wr, wc, fr, fq, lds, wid, lane); S.done(cur); }
    PG8_STAMP();
    if (STAMP && wid == 0) { stamps[lane] = lane < nts ? (((unsigned long long)(unsigned)ts_hi << 32) | (unsigned)ts_lo) : 0ull;
        if (lane == 62) stamps[62] = rt_entry; if (lane == 63) stamps[63] = (unsigned long long)wall_clock64(); }
#undef PG8_STAMP
#undef PG8_SA
#undef PG8_SB
#undef PG8_STAGE
#undef PG8_LDA
#undef PG8_LDB
#undef PG8_MMA
#undef PG8_WAIT_V
#undef PG8_WAIT_L
#undef PG8_BAR
#undef PG8_SCHED
}
}

using pg8::bf16_t; using pg8::bf16x8; using pg8::f32x4; using pg8::u32x4; using pg8::Unit;
typedef unsigned u32x2 __attribute__((ext_vector_type(2)));

constexpr int DM = 1024, NB = 4, SEQL = 4096, NTOK = NB * SEQL, CTXL = 256, NCTX = NB * CTXL, MROWS = NTOK + NCTX;
constexpr int DFF = 2816, INCOLS = 8224, NH = 8, HD = 128;
constexpr int OFF_Q = 2080, OFF_Z = 3104, OFF_U = 4128, OFF_AV = 5152, OFF_GA = 6176, OFF_GB = 7200;
constexpr float EPS = 1e-6f;
constexpr int LDS_BYTES = 131072 + 4096;
constexpr int NPHASE = 15;

constexpr size_t MiB = 1048576;
constexpr size_t WS_W1T = 0, WS_WAT = 16 * MiB + MiB / 2, WS_WBT = WS_WAT + 2 * MiB, WS_WOT = WS_WBT + 2 * MiB, WS_WUPT = WS_WOT + 2 * MiB, WS_WDT = WS_WUPT + 11 * MiB;
constexpr size_t WS_MOD = 39 * MiB, WS_BA = 39 * MiB + MiB / 4, WS_BETA = 41 * MiB + MiB / 2, WS_G = 42 * MiB + 3 * MiB / 4;
constexpr size_t WS_A1 = 44 * MiB;
constexpr size_t WS_R1 = 78 * MiB;
constexpr size_t WS_QRAW = WS_R1 + 68 * MiB;
constexpr size_t WS_ZS = WS_R1, WS_GA = WS_R1 + 32 * MiB, WS_GB = WS_R1 + 64 * MiB;
constexpr size_t WS_AA = 178 * MiB;
constexpr size_t WS_QN = 210 * MiB;
constexpr size_t WS_KNC = 242 * MiB, WS_VNC = 244 * MiB;
constexpr size_t WS_END = 246 * MiB;

__device__ __forceinline__ unsigned f2bf(float f) { unsigned u = __float_as_uint(f); return (u + 0x7fffu + ((u >> 16) & 1u)) >> 16; }
__device__ __forceinline__ unsigned pk2(float lo, float hi) { return f2bf(lo) | (f2bf(hi) << 16); }
__device__ __forceinline__ float bflo(unsigned w) { return __uint_as_float(w << 16); }
__device__ __forceinline__ float bfhi(unsigned w) { return __uint_as_float(w & 0xffff0000u); }
__device__ __forceinline__ float bf1(bf16_t b) { return __uint_as_float(((unsigned)b) << 16); }
__device__ __forceinline__ float sigmoidf_(float x) { return __builtin_amdgcn_rcpf(1.0f + __expf(-x)); }
__device__ __forceinline__ float siluf_(float x) { return x * sigmoidf_(x); }
__device__ __forceinline__ float geluf_(float x) { const float t = 1.5957691216f * (x + 0.044715f * x * x * x); return x * sigmoidf_(t); }
__device__ __forceinline__ float act_apply(float x, int act) { return act == 1 ? geluf_(x) : (act == 2 ? siluf_(x) : (act == 3 ? sigmoidf_(x) : x)); }
__device__ __forceinline__ float wave_sum(float v) {
#pragma unroll
    for (int o = 1; o < 64; o <<= 1) v += __shfl_xor(v, o);
    return v;
}
#define LDS_WAIT() asm volatile("s_waitcnt lgkmcnt(0)" ::: "memory")

struct EpiSel {
    static constexpr bool PERM = true, AFTER_DRAIN = false;
    bf16_t *O0, *O1, *O2, *O3, *O4; int ld0, ld1, ld2, ld3, ld4; int a0, a1, a2, a3, a4; int ba_pn; float* BA;
    __device__ __forceinline__ void operator()(const f32x4 (&acc)[2][2][4][2], const Unit& u, int wr, int wc, int fr, int fq) const {
        const int row0 = u.pm * 256 + wr * 64 + fr;
        if (u.pn == ba_pn) {
            if (wc == 0) {
#pragma unroll
                for (int ai = 0; ai < 2; ++ai)
#pragma unroll
                    for (int m = 0; m < 4; ++m) { float* rp = BA + (size_t)(row0 + ai * 128 + m * 16) * 32 + 8 * fq;
#pragma unroll
                        for (int n = 0; n < 2; ++n) *(f32x4*)(rp + 4 * n) = acc[ai][0][m][n]; }
            }
            return;
        }
        const int g = u.pn >> 2;
        bf16_t* O = g == 0 ? O0 : (g == 1 ? O1 : (g == 2 ? O2 : (g == 3 ? O3 : O4)));
        const int ldc = g == 0 ? ld0 : (g == 1 ? ld1 : (g == 2 ? ld2 : (g == 3 ? ld3 : ld4)));
        const int act = g == 0 ? a0 : (g == 1 ? a1 : (g == 2 ? a2 : (g == 3 ? a3 : a4)));
        const int col0 = (u.pn & 3) * 256 + wc * 32 + 8 * fq;
#pragma unroll
        for (int ai = 0; ai < 2; ++ai)
#pragma unroll
            for (int m = 0; m < 4; ++m) { bf16_t* rowp = O + (size_t)(row0 + ai * 128 + m * 16) * ldc + col0;
#pragma unroll
                for (int bj = 0; bj < 2; ++bj) { f32x4 v0 = acc[ai][bj][m][0], v1 = acc[ai][bj][m][1];
                    if (act) {
#pragma unroll
                        for (int j = 0; j < 4; ++j) { v0[j] = act_apply(v0[j], act); v1[j] = act_apply(v1[j], act); } }
                    u32x4 w; w.x = pk2(v0[0], v0[1]); w.y = pk2(v0[2], v0[3]); w.z = pk2(v1[0], v1[1]); w.w = pk2(v1[2], v1[3]);
                    *(u32x4*)(rowp + bj * 128) = w; } }
    }
};
struct EpiGate {
    static constexpr bool PERM = true, AFTER_DRAIN = false;
    const bf16_t* G; const bf16_t* T; bf16_t* O;
    __device__ __forceinline__ void operator()(const f32x4 (&acc)[2][2][4][2], const Unit& u, int wr, int wc, int fr, int fq) const {
        const int row0 = u.pm * 256 + wr * 64 + fr, col0 = u.pn * 256 + wc * 32 + 8 * fq;
#pragma unroll
        for (int ai = 0; ai < 2; ++ai)
#pragma unroll
            for (int m = 0; m < 4; ++m) { const size_t off = (size_t)(row0 + ai * 128 + m * 16) * DM + col0;
#pragma unroll
                for (int bj = 0; bj < 2; ++bj) { const f32x4 v0 = acc[ai][bj][m][0], v1 = acc[ai][bj][m][1];
                    const u32x4 gw = *(const u32x4*)(G + off + bj * 128);
                    float r[8];
                    r[0] = v0[0] * bflo(gw.x); r[1] = v0[1] * bfhi(gw.x); r[2] = v0[2] * bflo(gw.y); r[3] = v0[3] * bfhi(gw.y);
                    r[4] = v1[0] * bflo(gw.z); r[5] = v1[1] * bfhi(gw.z); r[6] = v1[2] * bflo(gw.w); r[7] = v1[3] * bfhi(gw.w);
                    if (T) { const u32x4 tw = *(const u32x4*)(T + off + bj * 128);
                        r[0] += bflo(tw.x); r[1] += bfhi(tw.x); r[2] += bflo(tw.y); r[3] += bfhi(tw.y); r[4] += bflo(tw.z); r[5] += bfhi(tw.z); r[6] += bflo(tw.w); r[7] += bfhi(tw.w); }
                    u32x4 w; w.x = pk2(r[0], r[1]); w.y = pk2(r[2], r[3]); w.z = pk2(r[4], r[5]); w.w = pk2(r[6], r[7]);
                    *(u32x4*)(O + off + bj * 128) = w; } }
    }
};
struct EpiRes {
    static constexpr bool PERM = false, AFTER_DRAIN = false;
    const float* base; float* out; const float* gate;
    __device__ __forceinline__ void operator()(const f32x4 (&acc)[2][2][4][2], const Unit& u, int wr, int wc, int fr, int fq) const {
        const int row0 = u.pm * 256 + wr * 64 + fr, col0 = u.pn * 256 + wc * 32 + 4 * fq;
        const float* gp = gate + (size_t)(u.pm >> 4) * 6144 + col0;
        f32x4 gv[2][2];
#pragma unroll
        for (int bj = 0; bj < 2; ++bj)
#pragma unroll
            for (int n = 0; n < 2; ++n) gv[bj][n] = *(const f32x4*)(gp + bj * 128 + n * 16);
#pragma unroll
        for (int ai = 0; ai < 2; ++ai)
#pragma unroll
            for (int m = 0; m < 4; ++m) { const size_t off = (size_t)(row0 + ai * 128 + m * 16) * DM + col0;
#pragma unroll
                for (int bj = 0; bj < 2; ++bj)
#pragma unroll
                    for (int n = 0; n < 2; ++n) { const f32x4 bs = *(const f32x4*)(base + off + bj * 128 + n * 16);
                        *(f32x4*)(out + off + bj * 128 + n * 16) = bs + gv[bj][n] * acc[ai][bj][m][n]; } }
    }
};
struct EpiUp {
    static constexpr bool PERM = true, AFTER_DRAIN = false;
    const float* cw; const float* cb; bf16_t* ACT;
    __device__ __forceinline__ void operator()(const f32x4 (&acc)[2][2][4][2], const Unit& u, int wr, int wc, int fr, int fq) const {
        const int lane = (int)(threadIdx.x & 63);
        const int chb = u.pn * 128 + wc * 32 + 8 * fq;
        const int row0 = u.pm * 256 + wr * 64 + fr;
        f32x4 w0[2], w1[2], w2[2], bb[2];
#pragma unroll
        for (int n = 0; n < 2; ++n) { w0[n] = *(const f32x4*)(cw + chb + 4 * n); w1[n] = *(const f32x4*)(cw + DFF + chb + 4 * n); w2[n] = *(const f32x4*)(cw + 2 * DFF + chb + 4 * n); bb[n] = *(const f32x4*)(cb + chb + 4 * n); }
#pragma unroll
        for (int ai = 0; ai < 2; ++ai)
#pragma unroll
            for (int m = 0; m < 4; ++m) {
                float r[8];
#pragma unroll
                for (int n = 0; n < 2; ++n)
#pragma unroll
                    for (int e = 0; e < 4; ++e) {
                        const float cur = acc[ai][0][m][n][e];
                        const float pv_same = __shfl(cur, lane - 1);
                        const float pv_wrap = (m > 0) ? __shfl(acc[ai][0][m > 0 ? m - 1 : 0][n][e], lane + 15) : 0.f;
                        const float nx_same = __shfl(cur, lane + 1);
                        const float nx_wrap = (m < 3) ? __shfl(acc[ai][0][m < 3 ? m + 1 : 3][n][e], lane - 15) : 0.f;
                        const float prev = fr > 0 ? pv_same : pv_wrap;
                        const float next = fr < 15 ? nx_same : nx_wrap;
                        const float a = w0[n][e] * prev + w1[n][e] * cur + w2[n][e] * next + bb[n][e];
                        r[n * 4 + e] = geluf_(a) * acc[ai][1][m][n][e];
                    }
                u32x4 w; w.x = pk2(r[0], r[1]); w.y = pk2(r[2], r[3]); w.z = pk2(r[4], r[5]); w.w = pk2(r[6], r[7]);
                *(u32x4*)(ACT + (size_t)(row0 + ai * 128 + m * 16) * DFF + chb) = w;
            }
    }
};

struct Order1a {
    int G, c;
    __device__ bool next(int i, Unit& u) const {
        const int L = i * G + c;
        if (L < 64 * 21) { const int grp = L / 168, r = L % 168; u.pm = grp * 8 + (r & 7); u.pn = r >> 3; return true; }
        const int r = L - 64 * 21; if (r >= 36) return false;
        u.pm = 64 + (r & 3); const int q = r >> 2; u.pn = q < 8 ? q : 20; return true;
    }
    __device__ __forceinline__ void a_ready(const Unit&) const {}
    __device__ __forceinline__ void done(const Unit&) const {}
};

struct Args { const float* in[25]; float* out; unsigned char* ws; int ph_lo, ph_hi, coop, pad; };

__device__ __forceinline__ void transpose_item(const float* __restrict__ W, int N, int srccol0, int k0, bf16_t* WT, int K, int drow0, float* scr, int lane) {
    if (srccol0 >= 0) {
#pragma unroll 8
        for (int i = 0; i < 32; ++i) { const int kk = 2 * i + (lane >> 5); scr[kk * 33 + (lane & 31)] = W[(size_t)(k0 + kk) * N + srccol0 + (lane & 31)]; }
    } else {
#pragma unroll 8
        for (int i = 0; i < 32; ++i) { const int kk = 2 * i + (lane >> 5); scr[kk * 33 + (lane & 31)] = 0.f; }
    }
    LDS_WAIT();
    const int c = lane & 7;
#pragma unroll
    for (int j = 0; j < 4; ++j) { const int n = (lane >> 3) + 8 * j; const float* s = scr + (8 * c) * 33 + n;
        u32x4 o; o.x = pk2(s[0 * 33], s[1 * 33]); o.y = pk2(s[2 * 33], s[3 * 33]); o.z = pk2(s[4 * 33], s[5 * 33]); o.w = pk2(s[6 * 33], s[7 * 33]);
        *(u32x4*)(WT + (size_t)(drow0 + n) * K + k0 + 8 * c) = o; }
    LDS_WAIT();
}

__device__ __forceinline__ int w1t_srccol(int nb) {
    if (nb < 64) return nb * 32;
    if (nb < 96) return OFF_Q + (nb - 64) * 32;
    if (nb < 128) return OFF_U + (nb - 96) * 32;
    if (nb < 160) return OFF_AV + (nb - 128) * 32;
    if (nb == 160) return 2048;
    if (nb < 168) return -1;
    if (nb < 200) return OFF_Z + (nb - 168) * 32;
    if (nb < 232) return OFF_GA + (nb - 200) * 32;
    return OFF_GB + (nb - 232) * 32;
}

__device__ __forceinline__ void phase0(const Args& a, unsigned char* shm, int gw, int NGW, int wave, int lane, int tid) {
    unsigned char* ws = a.ws;
    float* scr = (float*)(shm + wave * 16384);
    constexpr int I1 = 264 * 16, IA = 32 * 16, IU = 176 * 16, ID = 32 * 44;
    constexpr int NIT = I1 + 3 * IA + IU + ID;
    for (int it = gw; it < NIT; it += NGW) {
        int r = it;
        if (r < I1) { const int nb = r >> 4, kb = r & 15; transpose_item(a.in[7], INCOLS, w1t_srccol(nb), kb * 64, (bf16_t*)(ws + WS_W1T), DM, nb * 32, scr, lane); continue; } r -= I1;
        if (r < IA) { const int nb = r >> 4, kb = r & 15; transpose_item(a.in[17], DM, nb * 32, kb * 64, (bf16_t*)(ws + WS_WAT), DM, nb * 32, scr, lane); continue; } r -= IA;
        if (r < IA) { const int nb = r >> 4, kb = r & 15; transpose_item(a.in[12], DM, nb * 32, kb * 64, (bf16_t*)(ws + WS_WBT), DM, nb * 32, scr, lane); continue; } r -= IA;
        if (r < IA) { const int nb = r >> 4, kb = r & 15; transpose_item(a.in[18], DM, nb * 32, kb * 64, (bf16_t*)(ws + WS_WOT), DM, nb * 32, scr, lane); continue; } r -= IA;
        if (r < IU) { const int nb = r >> 4, kb = r & 15; const int j = nb >> 3, wi = nb & 7; const int sc = wi < 4 ? (128 * j + 32 * wi) : (DFF + 128 * j + 32 * (wi - 4));
            transpose_item(a.in[20], 2 * DFF, sc, kb * 64, (bf16_t*)(ws + WS_WUPT), DM, nb * 32, scr, lane); continue; } r -= IU;
        { const int nb = r / 44, kb = r % 44; transpose_item(a.in[23], DM, nb * 32, kb * 64, (bf16_t*)(ws + WS_WDT), DFF, nb * 32, scr, lane); }
    }
    __syncthreads();
    float* red = (float*)shm;
    const float* wm = a.in[4]; const float* bm = a.in[5]; const float* cin = a.in[1]; const float* cctx = a.in[3];
    float* MOD = (float*)(ws + WS_MOD);
    for (int it = blockIdx.x; it < 192; it += gridDim.x) {
        const int c = tid & 31, kq = tid >> 5, col0 = it * 32;
        float s0 = 0.f, s1 = 0.f, s2 = 0.f, s3 = 0.f, s4 = 0.f;
        for (int kk = 0; kk < 64; ++kk) { const int k = kq * 64 + kk; const float w = wm[(size_t)k * 6144 + col0 + c];
            s0 += siluf_(cin[k]) * w; s1 += siluf_(cin[1024 + k]) * w; s2 += siluf_(cin[2048 + k]) * w; s3 += siluf_(cin[3072 + k]) * w; s4 += siluf_(cctx[k]) * w; }
        red[(kq * 5 + 0) * 32 + c] = s0; red[(kq * 5 + 1) * 32 + c] = s1; red[(kq * 5 + 2) * 32 + c] = s2; red[(kq * 5 + 3) * 32 + c] = s3; red[(kq * 5 + 4) * 32 + c] = s4;
        __syncthreads();
        if (tid < 160) { const int b = tid >> 5, cc = tid & 31; float s = 0.f;
            for (int q = 0; q < 16; ++q) s += red[(q * 5 + b) * 32 + cc];
            MOD[b * 6144 + col0 + cc] = s + bm[col0 + cc]; }
        __syncthreads();
    }
}

__device__ __forceinline__ void norm_mod_rows(const float* X, int nx, const float* X2, int n2, const float* g, const float* MOD, int sh_off, int sc_off, bf16_t* out, int gw, int NGW, int lane) {
    for (int r = gw; r < nx + n2; r += NGW) {
        const float* src = r < nx ? X + (size_t)r * DM : X2 + (size_t)(r - nx) * DM;
        const int mb = r < nx ? (r >> 12) : 4;
        f32x4 v[4]; float ss = 0.f;
#pragma unroll
        for (int j = 0; j < 4; ++j) { v[j] = *(const f32x4*)(src + 4 * lane + 256 * j); ss += (v[j][0] * v[j][0] + v[j][1] * v[j][1]) + (v[j][2] * v[j][2] + v[j][3] * v[j][3]); }
        ss = wave_sum(ss);
        const float rs = 1.0f / sqrtf(ss * (1.0f / DM) + EPS);
        const float* mp = MOD + (size_t)mb * 6144;
#pragma unroll
        for (int j = 0; j < 4; ++j) { const int col = 4 * lane + 256 * j;
            const f32x4 gg = *(const f32x4*)(g + col), sh = *(const f32x4*)(mp + sh_off + col), sc = *(const f32x4*)(mp + sc_off + col);
            const f32x4 y = v[j] * rs * gg; const f32x4 h = y * (1.0f + sc) + sh;
            u32x2 w; w.x = pk2(h[0], h[1]); w.y = pk2(h[2], h[3]);
            *(u32x2*)(out + (size_t)r * DM + col) = w; }
    }
}

__device__ __forceinline__ void phase_branch_a(const Args& a, unsigned char* shm, const bf16_t* UG, const bf16_t* VG, bf16_t* AA, int wave, int lane, int tid) {
    bf16_t* VnT = (bf16_t*)shm;
    bf16_t* WsL = VnT + 128 * 136;
    float* stat = (float*)(shm + 2 * 128 * 136 * 2);
    const float* ln_g = a.in[13]; const float* ln_b = a.in[14]; const float* a_ws = a.in[15]; const float* a_bs = a.in[16];
    for (int it = blockIdx.x; it < 256; it += gridDim.x) {
        const int chunk = it >> 1, gh = it & 1, tok0 = chunk * 128;
        for (int tt = 0; tt < 16; ++tt) { const int t = wave * 16 + tt; const bf16_t* row = VG + (size_t)(tok0 + t) * DM + lane * 16;
            const u32x4 p0 = *(const u32x4*)row, p1 = *(const u32x4*)(row + 8);
            const unsigned w8[8] = {p0.x, p0.y, p0.z, p0.w, p1.x, p1.y, p1.z, p1.w};
            float s = 0.f, q = 0.f;
#pragma unroll
            for (int e = 0; e < 8; ++e) { const float x0 = bflo(w8[e]), x1 = bfhi(w8[e]); s += x0 + x1; q += x0 * x0 + x1 * x1; }
            s = wave_sum(s); q = wave_sum(q);
            const float mean = s * (1.0f / DM); const float var = q * (1.0f / DM) - mean * mean;
            if (lane == 0) { stat[2 * t] = mean; stat[2 * t + 1] = 1.0f / sqrtf(fmaxf(var, 0.f) + EPS); }
        }
        __syncthreads();
        for (int gi = 0; gi < 4; ++gi) {
            const int g = gh * 4 + gi;
            { const int j = tid >> 2, cq = (tid & 3) * 32; const float mean = stat[2 * j], rstd = stat[2 * j + 1];
              const bf16_t* src = VG + (size_t)(tok0 + j) * DM + g * 128 + cq;
#pragma unroll
              for (int v4 = 0; v4 < 4; ++v4) { const u32x4 p = *(const u32x4*)(src + 8 * v4); const unsigned w4[4] = {p.x, p.y, p.z, p.w};
#pragma unroll
                  for (int e = 0; e < 4; ++e) { const int cl = cq + 8 * v4 + 2 * e; const int ch = g * 128 + cl;
                      const float y0 = (bflo(w4[e]) - mean) * rstd * ln_g[ch] + ln_b[ch], y1 = (bfhi(w4[e]) - mean) * rstd * ln_g[ch + 1] + ln_b[ch + 1];
                      VnT[cl * 136 + j] = (bf16_t)f2bf(y0); VnT[(cl + 1) * 136 + j] = (bf16_t)f2bf(y1); } }
              const int i = tid >> 2, jq = (tid & 3) * 32; const float* wsrc = a_ws + ((size_t)g * 128 + i) * 128 + jq;
#pragma unroll
              for (int v4 = 0; v4 < 4; ++v4) { const f32x4 x0 = *(const f32x4*)(wsrc + 8 * v4), x1 = *(const f32x4*)(wsrc + 8 * v4 + 4);
                  u32x4 o; o.x = pk2(x0[0], x0[1]); o.y = pk2(x0[2], x0[3]); o.z = pk2(x1[0], x1[1]); o.w = pk2(x1[2], x1[3]);
                  *(u32x4*)(WsL + i * 136 + jq + 8 * v4) = o; }
            }
            __syncthreads();
            const int cb = (wave >> 1) * 32, ib = (wave & 1) * 64, lr = lane & 15, lq = lane >> 4;
            f32x4 acc[2][4];
#pragma unroll
            for (int m = 0; m < 2; ++m)
#pragma unroll
                for (int n = 0; n < 4; ++n) acc[m][n] = (f32x4){0.f, 0.f, 0.f, 0.f};
#pragma unroll
            for (int ks = 0; ks < 4; ++ks) { bf16x8 af[2], bfr[4];
#pragma unroll
                for (int m = 0; m < 2; ++m) af[m] = *(const bf16x8*)(VnT + (cb + 16 * m + lr) * 136 + ks * 32 + 8 * lq);
#pragma unroll
                for (int n = 0; n < 4; ++n) bfr[n] = *(const bf16x8*)(WsL + (ib + 16 * n + lr) * 136 + ks * 32 + 8 * lq);
#pragma unroll
                for (int m = 0; m < 2; ++m)
#pragma unroll
                    for (int n = 0; n < 4; ++n) acc[m][n] = __builtin_amdgcn_mfma_f32_16x16x32_bf16(af[m], bfr[n], acc[m][n], 0, 0, 0); }
#pragma unroll
            for (int m = 0; m < 2; ++m)
#pragma unroll
                for (int n = 0; n < 4; ++n) { const int i = ib + 16 * n + lr; const float bs = a_bs[g * 128 + i]; const int ch = g * 128 + cb + 16 * m + lq * 4;
                    const size_t off = (size_t)(tok0 + i) * DM + ch;
                    const u32x2 uw = *(const u32x2*)(UG + off);
                    u32x2 o; o.x = pk2(bflo(uw.x) * (acc[m][n][0] + bs), bfhi(uw.x) * (acc[m][n][1] + bs)); o.y = pk2(bflo(uw.y) * (acc[m][n][2] + bs), bfhi(uw.y) * (acc[m][n][3] + bs));
                    *(u32x2*)(AA + off) = o; }
            __syncthreads();
        }
    }
}

__device__ __forceinline__ void phase_conv_prep(const Args& a, const bf16_t* KV, const bf16_t* QR, const float* BA, bf16_t* KNx, bf16_t* VNx, bf16_t* KNc, bf16_t* VNc, bf16_t* QN, float* BETA, float* GG, int gw, int NGW, int lane) {
    const float* cw = a.in[8];
    for (int r = gw; r < MROWS; r += NGW) {
        const bool isx = r < NTOK; const int t = isx ? (r & (SEQL - 1)) : ((r - NTOK) & (CTXL - 1)); const int Ls = isx ? SEQL : CTXL;
        const bool hasp = t > 0, hasn = t < Ls - 1;
        for (int typ = 0; typ < 3; ++typ) {
            if (typ == 2 && !isx) break;
            const bf16_t* src = typ < 2 ? KV + (size_t)r * 2048 + typ * 1024 + lane * 16 : QR + (size_t)r * 1024 + lane * 16;
            const int ld = typ < 2 ? 2048 : 1024;
            const u32x4 z4 = (u32x4){0u, 0u, 0u, 0u};
            const u32x4 c0 = *(const u32x4*)src, c1 = *(const u32x4*)(src + 8);
            const u32x4 p0 = hasp ? *(const u32x4*)(src - ld) : z4, p1 = hasp ? *(const u32x4*)(src - ld + 8) : z4;
            const u32x4 n0 = hasn ? *(const u32x4*)(src + ld) : z4, n1 = hasn ? *(const u32x4*)(src + ld + 8) : z4;
            const unsigned cu[8] = {c0.x, c0.y, c0.z, c0.w, c1.x, c1.y, c1.z, c1.w}, pu[8] = {p0.x, p0.y, p0.z, p0.w, p1.x, p1.y, p1.z, p1.w}, nu[8] = {n0.x, n0.y, n0.z, n0.w, n1.x, n1.y, n1.z, n1.w};
            const float* wp = cw + typ * 1024 + lane * 16;
            float y[16]; float ss = 0.f;
#pragma unroll
            for (int e = 0; e < 8; ++e) {
                const float w00 = wp[2 * e], w01 = wp[2 * e + 1], w10 = wp[3072 + 2 * e], w11 = wp[3072 + 2 * e + 1], w20 = wp[6144 + 2 * e], w21 = wp[6144 + 2 * e + 1];
                const float a0 = w00 * bflo(pu[e]) + w10 * bflo(cu[e]) + w20 * bflo(nu[e]), a1 = w01 * bfhi(pu[e]) + w11 * bfhi(cu[e]) + w21 * bfhi(nu[e]);
                y[2 * e] = siluf_(a0); y[2 * e + 1] = siluf_(a1); ss += y[2 * e] * y[2 * e] + y[2 * e + 1] * y[2 * e + 1]; }
            if (typ != 1) { ss += __shfl_xor(ss, 1); ss += __shfl_xor(ss, 2); ss += __shfl_xor(ss, 4);
                const float sc = (1.0f / sqrtf(ss + EPS)) * (typ == 2 ? 0.08838834764831845f : 1.0f);
#pragma unroll
                for (int e = 0; e < 16; ++e) y[e] *= sc; }
            bf16_t* dst = typ == 0 ? (isx ? KNx + (size_t)r * DM : KNc + (size_t)(r - NTOK) * DM) : (typ == 1 ? (isx ? VNx + (size_t)r * DM : VNc + (size_t)(r - NTOK) * DM) : QN + (size_t)r * DM);
            u32x4 o0, o1; o0.x = pk2(y[0], y[1]); o0.y = pk2(y[2], y[3]); o0.z = pk2(y[4], y[5]); o0.w = pk2(y[6], y[7]); o1.x = pk2(y[8], y[9]); o1.y = pk2(y[10], y[11]); o1.z = pk2(y[12], y[13]); o1.w = pk2(y[14], y[15]);
            *(u32x4*)(dst + lane * 16) = o0; *(u32x4*)(dst + lane * 16 + 8) = o1;
        }
        if (lane < 16) { const int dir = lane >> 3, h = lane & 7;
            const float bl = BA[(size_t)r * 32 + dir * 8 + h], al = BA[(size_t)r * 32 + 16 + dir * 8 + h] + a.in[10][dir * 8 + h];
            const float sp = fmaxf(al, 0.f) + log1pf(__expf(-fabsf(al)));
            BETA[((size_t)dir * MROWS + r) * 8 + h] = sigmoidf_(bl);
            GG[((size_t)dir * MROWS + r) * 8 + h] = -__expf(a.in[9][dir * 8 + h]) * sp; }
    }
}

__device__ __forceinline__ void phase_scan(const bf16_t* KNx, const bf16_t* VNx, const bf16_t* KNc, const bf16_t* VNc, const bf16_t* QN, const float* BETA, const float* GG, bf16_t* OF, bf16_t* OB, int gw, int NGW, int lane) {
    constexpr int UNR = 8;
    for (int it = gw; it < 2048; it += NGW) {
        const int sl = it & 31, h = (it >> 5) & 7, b = (it >> 8) & 3, dir = it >> 10;
        const int kk = lane >> 2, c = lane & 3, dvc = sl * 4 + c;
        float S[8];
#pragma unroll
        for (int i = 0; i < 8; ++i) S[i] = 0.f;
        bf16_t* O = dir ? OB : OF;
        for (int seg = 0; seg < 2; ++seg) {
            const int n = seg ? SEQL : CTXL;
            const bf16_t* Kb = (seg ? KNx + (size_t)b * SEQL * DM : KNc + (size_t)b * CTXL * DM) + h * 128;
            const bf16_t* Vb = (seg ? VNx + (size_t)b * SEQL * DM : VNc + (size_t)b * CTXL * DM) + h * 128;
            const bf16_t* Qb = QN + (size_t)b * SEQL * DM + h * 128;
            const size_t rb = (size_t)dir * MROWS + (seg ? b * SEQL : NTOK + b * CTXL);
            for (int s0 = 0; s0 < n; s0 += UNR) {
                u32x4 kq[UNR], qq[UNR]; bf16_t vv[UNR]; float be[UNR], gg[UNR];
#pragma unroll
                for (int j = 0; j < UNR; ++j) { const int s = s0 + j; const int t = dir ? n - 1 - s : s;
                    kq[j] = *(const u32x4*)(Kb + (size_t)t * DM + kk * 8);
                    qq[j] = seg ? *(const u32x4*)(Qb + (size_t)t * DM + kk * 8) : (u32x4){0u, 0u, 0u, 0u};
                    vv[j] = Vb[(size_t)t * DM + dvc];
                    be[j] = BETA[(rb + t) * 8 + h]; gg[j] = GG[(rb + t) * 8 + h]; }
#pragma unroll
                for (int j = 0; j < UNR; ++j) { const int s = s0 + j; const int t = dir ? n - 1 - s : s;
                    const float e = __expf(gg[j]);
                    float kf[8] = {bflo(kq[j].x), bfhi(kq[j].x), bflo(kq[j].y), bfhi(kq[j].y), bflo(kq[j].z), bfhi(kq[j].z), bflo(kq[j].w), bfhi(kq[j].w)};
                    float part = 0.f;
#pragma unroll
                    for (int i = 0; i < 8; ++i) part += kf[i] * S[i];
                    part += __shfl_xor(part, 4); part += __shfl_xor(part, 8); part += __shfl_xor(part, 16); part += __shfl_xor(part, 32);
                    const float delta = be[j] * (bf1(vv[j]) - e * part);
#pragma unroll
                    for (int i = 0; i < 8; ++i) S[i] = e * S[i] + kf[i] * delta;
                    if (seg) {
                        float qf[8] = {bflo(qq[j].x), bfhi(qq[j].x), bflo(qq[j].y), bfhi(qq[j].y), bflo(qq[j].z), bfhi(qq[j].z), bflo(qq[j].w), bfhi(qq[j].w)};
                        float po = 0.f;
#pragma unroll
                        for (int i = 0; i < 8; ++i) po += qf[i] * S[i];
                        po += __shfl_xor(po, 4); po += __shfl_xor(po, 8); po += __shfl_xor(po, 16); po += __shfl_xor(po, 32);
                        if (kk == 0) O[((size_t)b * SEQL + t) * DM + h * 128 + dvc] = (bf16_t)f2bf(po);
                    }
                }
            }
        }
    }
}

__device__ __forceinline__ void phase_ogate(const Args& a, bf16_t* OF, const bf16_t* OB, const bf16_t* ZS, int gw, int NGW, int lane) {
    const float* og = a.in[11];
    for (int r = gw; r < NTOK; r += NGW) {
        const size_t off = (size_t)r * DM + lane * 16;
        const u32x4 f0 = *(const u32x4*)(OF + off), f1 = *(const u32x4*)(OF + off + 8), b0 = *(const u32x4*)(OB + off), b1 = *(const u32x4*)(OB + off + 8), z0 = *(const u32x4*)(ZS + off), z1 = *(const u32x4*)(ZS + off + 8);
        const unsigned fu[8] = {f0.x, f0.y, f0.z, f0.w, f1.x, f1.y, f1.z, f1.w}, bu[8] = {b0.x, b0.y, b0.z, b0.w, b1.x, b1.y, b1.z, b1.w}, zu[8] = {z0.x, z0.y, z0.z, z0.w, z1.x, z1.y, z1.z, z1.w};
        float o[16]; float ss = 0.f;
#pragma unroll
        for (int e = 0; e < 8; ++e) { o[2 * e] = bflo(fu[e]) + bflo(bu[e]); o[2 * e + 1] = bfhi(fu[e]) + bfhi(bu[e]); ss += o[2 * e] * o[2 * e] + o[2 * e + 1] * o[2 * e + 1]; }
        ss += __shfl_xor(ss, 1); ss += __shfl_xor(ss, 2); ss += __shfl_xor(ss, 4);
        const float rs = 1.0f / sqrtf(ss * (1.0f / HD) + EPS);
        const float* gp = og + (lane & 7) * 16;
        unsigned w[8];
#pragma unroll
        for (int e = 0; e < 8; ++e) w[e] = pk2(o[2 * e] * rs * gp[2 * e] * bflo(zu[e]), o[2 * e + 1] * rs * gp[2 * e + 1] * bfhi(zu[e]));
        *(u32x4*)(OF + off) = (u32x4){w[0], w[1], w[2], w[3]}; *(u32x4*)(OF + off + 8) = (u32x4){w[4], w[5], w[6], w[7]};
    }
}

__device__ __forceinline__ void phase_final(float* X, const float* g, int gw, int NGW, int lane) {
    for (int r = gw; r < NTOK; r += NGW) {
        float* src = X + (size_t)r * DM;
        f32x4 v[4]; float ss = 0.f;
#pragma unroll
        for (int j = 0; j < 4; ++j) { v[j] = *(const f32x4*)(src + 4 * lane + 256 * j); ss += (v[j][0] * v[j][0] + v[j][1] * v[j][1]) + (v[j][2] * v[j][2] + v[j][3] * v[j][3]); }
        ss = wave_sum(ss);
        const float rs = 1.0f / sqrtf(ss * (1.0f / DM) + EPS);
#pragma unroll
        for (int j = 0; j < 4; ++j) { const f32x4 gg = *(const f32x4*)(g + 4 * lane + 256 * j); *(f32x4*)(src + 4 * lane + 256 * j) = v[j] * rs * gg; }
    }
}

__global__ void __launch_bounds__(512, 2) mk_fwd(Args a) {
    extern __shared__ __attribute__((aligned(16))) unsigned char shm[];
    const int tid = threadIdx.x, lane = tid & 63, wave = __builtin_amdgcn_readfirstlane(tid >> 6);
    const int G = gridDim.x, gw = blockIdx.x * 8 + wave, NGW = G * 8;
    unsigned char* ws = a.ws;
    PG8_LAS unsigned char* lds = (PG8_LAS unsigned char*)shm;
    const int lo = a.ph_lo, hi = a.ph_hi;
    float* MOD = (float*)(ws + WS_MOD);
    bf16_t* UG = (bf16_t*)a.out; bf16_t* VG = UG + (size_t)NTOK * DM;
    bf16_t* KNx = (bf16_t*)a.out; bf16_t* VNx = KNx + (size_t)NTOK * DM;
#define IN(k) (lo <= (k) && (k) < hi)
#define SEAM(k) do { if (IN(k) && IN((k) + 1)) { if (a.coop) cg::this_grid().sync(); } } while (0)

    if (IN(0)) { phase0(a, shm, gw, NGW, wave, lane, tid); } SEAM(0);
    if (IN(1)) { norm_mod_rows(a.in[0], NTOK, a.in[2], NCTX, a.in[6], MOD, 0, 1024, (bf16_t*)(ws + WS_A1), gw, NGW, lane); } SEAM(1);
    if (IN(2)) {
        pg8::Gemm g{(const bf16_t*)(ws + WS_A1), (const bf16_t*)(ws + WS_W1T), MROWS, 5376, DM};
        Order1a S{G, (int)blockIdx.x};
        EpiSel E{(bf16_t*)(ws + WS_R1), (bf16_t*)(ws + WS_R1) + 1024, (bf16_t*)(ws + WS_QRAW), UG, VG, 2048, 2048, 1024, 1024, 1024, 0, 0, 0, 1, 1, 20, (float*)(ws + WS_BA)};
        pg8::gemm_phase<EpiSel, Order1a, false>(lds, g, S, E, nullptr);
    } SEAM(2);
    if (IN(3)) { phase_branch_a(a, shm, UG, VG, (bf16_t*)(ws + WS_AA), wave, lane, tid); } SEAM(3);
    if (IN(4)) { phase_conv_prep(a, (const bf16_t*)(ws + WS_R1), (const bf16_t*)(ws + WS_QRAW), (const float*)(ws + WS_BA), KNx, VNx, (bf16_t*)(ws + WS_KNC), (bf16_t*)(ws + WS_VNC), (bf16_t*)(ws + WS_QN),
                                 (float*)(ws + WS_BETA), (float*)(ws + WS_G), gw, NGW, lane); } SEAM(4);
    if (IN(5)) {
        pg8::Gemm g{(const bf16_t*)(ws + WS_A1), (const bf16_t*)(ws + WS_W1T) + (size_t)5376 * DM, NTOK, 3072, DM};
        pg8::StaticOrder S; S.init(NTOK, 3072, G, (int)blockIdx.x);
        EpiSel E{(bf16_t*)(ws + WS_ZS), (bf16_t*)(ws + WS_GA), (bf16_t*)(ws + WS_GB), nullptr, nullptr, 1024, 1024, 1024, 0, 0, 2, 3, 3, 0, 0, -1, nullptr};
        pg8::gemm_phase<EpiSel, pg8::StaticOrder, false>(lds, g, S, E, nullptr);
    } SEAM(5);
    if (IN(6)) {
        pg8::Gemm g{(const bf16_t*)(ws + WS_AA), (const bf16_t*)(ws + WS_WAT), NTOK, DM, DM};
        pg8::StaticOrder S; S.init(NTOK, DM, G, (int)blockIdx.x);
        EpiGate E{(const bf16_t*)(ws + WS_GA), nullptr, (bf16_t*)(ws + WS_A1)};
        pg8::gemm_phase<EpiGate, pg8::StaticOrder, false>(lds, g, S, E, nullptr);
    } SEAM(6);
    if (IN(7)) { phase_scan(KNx, VNx, (const bf16_t*)(ws + WS_KNC), (const bf16_t*)(ws + WS_VNC), (const bf16_t*)(ws + WS_QN), (const float*)(ws + WS_BETA), (const float*)(ws + WS_G),
                            (bf16_t*)(ws + WS_AA), (bf16_t*)(ws + WS_GA), gw, NGW, lane); } SEAM(7);
    if (IN(8)) { phase_ogate(a, (bf16_t*)(ws + WS_AA), (const bf16_t*)(ws + WS_GA), (const bf16_t*)(ws + WS_ZS), gw, NGW, lane); } SEAM(8);
    if (IN(9)) {
        pg8::Gemm g{(const bf16_t*)(ws + WS_AA), (const bf16_t*)(ws + WS_WBT), NTOK, DM, DM};
        pg8::StaticOrder S; S.init(NTOK, DM, G, (int)blockIdx.x);
        EpiGate E{(const bf16_t*)(ws + WS_GB), (const bf16_t*)(ws + WS_A1), (bf16_t*)(ws + WS_QN)};
        pg8::gemm_phase<EpiGate, pg8::StaticOrder, false>(lds, g, S, E, nullptr);
    } SEAM(9);
    if (IN(10)) {
        pg8::Gemm g{(const bf16_t*)(ws + WS_QN), (const bf16_t*)(ws + WS_WOT), NTOK, DM, DM};
        pg8::StaticOrder S; S.init(NTOK, DM, G, (int)blockIdx.x);
        EpiRes E{a.in[0], a.out, MOD + 2048};
        pg8::gemm_phase<EpiRes, pg8::StaticOrder, false>(lds, g, S, E, nullptr);
    } SEAM(10);
    if (IN(11)) { norm_mod_rows(a.out, NTOK, nullptr, 0, a.in[19], MOD, 3072, 4096, (bf16_t*)(ws + WS_A1), gw, NGW, lane); } SEAM(11);
    if (IN(12)) {
        pg8::Gemm g{(const bf16_t*)(ws + WS_A1), (const bf16_t*)(ws + WS_WUPT), NTOK, 2 * DFF, DM};
        pg8::StaticOrder S; S.init(NTOK, 2 * DFF, G, (int)blockIdx.x);
        EpiUp E{a.in[21], a.in[22], (bf16_t*)(ws + WS_R1)};
        pg8::gemm_phase<EpiUp, pg8::StaticOrder, false>(lds, g, S, E, nullptr);
    } SEAM(12);
    if (IN(13)) {
        pg8::Gemm g{(const bf16_t*)(ws + WS_R1), (const bf16_t*)(ws + WS_WDT), NTOK, DM, DFF};
        pg8::StaticOrder S; S.init(NTOK, DM, G, (int)blockIdx.x);
        EpiRes E{a.out, a.out, MOD + 5120};
        pg8::gemm_phase<EpiRes, pg8::StaticOrder, false>(lds, g, S, E, nullptr);
    } SEAM(13);
    if (IN(14)) { phase_final(a.out, a.in[24], gw, NGW, lane); }
#undef IN
#undef SEAM
}

#ifndef MK_PER_PHASE
#define MK_PER_PHASE 1
#endif

extern "C" void kernel_launch(void* const* d_in, const int* in_sizes, int n_in, void* d_out, int out_size, void* d_ws, size_t ws_size, hipStream_t stream) {
    static int grid = 0;
    if (grid == 0) {
        if (n_in != 25 || out_size != NTOK * DM || ws_size < WS_END) { fprintf(stderr, "kernel_launch: unexpected shapes (n_in %d out %d ws %zu)\n", n_in, out_size, ws_size); grid = -1; return; }
        int dev = 0, cus = 0, per_cu = 0;
        if (hipGetDevice(&dev) != hipSuccess || hipDeviceGetAttribute(&cus, hipDeviceAttributeMultiprocessorCount, dev) != hipSuccess) { grid = -1; return; }
        if (hipFuncSetAttribute((const void*)mk_fwd, hipFuncAttributeMaxDynamicSharedMemorySize, LDS_BYTES) != hipSuccess) { fprintf(stderr, "kernel_launch: hipFuncSetAttribute failed\n"); grid = -1; return; }
        if (hipOccupancyMaxActiveBlocksPerMultiprocessor(&per_cu, (const void*)mk_fwd, 512, LDS_BYTES) != hipSuccess || per_cu < 1) { fprintf(stderr, "kernel_launch: occupancy query says %d\n", per_cu); per_cu = 1; }
        (void)hipGetLastError();
        grid = cus;
    }
    if (grid < 0) return;
    Args a{};
    for (int i = 0; i < 25; ++i) a.in[i] = (const float*)d_in[i];
    a.out = (float*)d_out; a.ws = (unsigned char*)d_ws;
#if MK_PER_PHASE
    for (int p = 0; p < NPHASE; ++p) { a.ph_lo = p; a.ph_hi = p + 1; a.coop = 0;
        hipLaunchKernelGGL(mk_fwd, dim3(grid), dim3(512), LDS_BYTES, stream, a); }
#else
    a.ph_lo = 0; a.ph_hi = NPHASE; a.coop = 1;
    void* args[] = {&a};
    hipError_t e = hipLaunchCooperativeKernel((const void*)mk_fwd, dim3(grid), dim3(512), args, LDS_BYTES, stream);
    if (e != hipSuccess) fprintf(stderr, "cooperative launch failed: %s (grid %d)\n", hipGetErrorString(e), grid);
#endif
}
```

```cpp
#include <hip/hip_runtime.h>
#include <hip/hip_cooperative_groups.h>
#include <cstdio>
#include <cstdint>
namespace cg = cooperative_groups;
namespace pg8 {
#define PG8_LAS __attribute__((address_space(3)))
typedef unsigned short bf16_t;
typedef short bf16x8 __attribute__((ext_vector_type(8)));
typedef float f32x4 __attribute__((ext_vector_type(4)));
typedef unsigned u32x4 __attribute__((ext_vector_type(4)));
constexpr int BM = 256, BK = 64, HALF = 128, HTB = HALF * BK * 2  , STAGE_BYTES = 8 * HTB, NXCD = 8, WGM = 2;

__host__ __device__ __forceinline__ int lds_byte(int r, int c) { const int st = (r >> 4) * 2 + (c >> 5), rr = r & 15, cc = c & 31, ob = rr * 64 + cc * 2; return st * 1024 + (ob ^ (((ob >> 9) & 1) << 5)); }
__host__ __device__ __forceinline__ void stage_rc(int b, int& R, int& C) { const int st = b / 1024, sb = b % 1024, swz = sb ^ (((sb >> 9) & 1) << 5); R = (st >> 1) * 16 + swz / 64; C = (st & 1) * 32 + (swz % 64) / 2; }
__host__ __device__ __forceinline__ int perm32(int rho) { const int n = rho >> 4, i = rho & 15; return 8 * (i >> 2) + 4 * n + (i & 3); }

struct Unit { int pm, pn; };
struct Gemm { const bf16_t* A; const bf16_t* Bt; int M, N, K; };

struct StaticOrder {
    int nM, nN, nwg, G, c;
    __host__ __device__ void init(int M, int N, int G_, int c_) { nM = M / BM; nN = N / BM; nwg = nM * nN; G = G_; c = c_; }
    __host__ __device__ bool next(int i, Unit& u) const {
        const long L = (long)i * G + c; if (L >= nwg) return false;
        int wgid = (int)L; { const int q = nwg / NXCD, r = nwg % NXCD, xcd = wgid % NXCD, off = wgid / NXCD; wgid = (xcd < r ? xcd * (q + 1) : r * (q + 1) + (xcd - r) * q) + off; }
        const int nig = WGM * nN, gid = wgid / nig, fm = gid * WGM, gsz = (nM - fm) < WGM ? (nM - fm) : WGM;
        u.pm = fm + ((wgid % nig) % gsz); u.pn = (wgid % nig) / gsz; return true;
    }
    __device__ __forceinline__ void a_ready(const Unit&) const {}
    __device__ __forceinline__ void done(const Unit&) const {}
};
__device__ __forceinline__ unsigned cvt_pk_bf16(float lo, float hi) { unsigned r; asm volatile("v_cvt_pk_bf16_f32 %0, %1, %2" : "=v"(r) : "v"(lo), "v"(hi)); return r; }
template <class T, class = void> struct has_keep_acc { static constexpr bool value = false; };
template <class T> struct has_keep_acc<T, decltype((void)T::KEEP_ACC)> { static constexpr bool value = true; };
template <class Epi, class Sched, bool STAMP = false>
__device__ __forceinline__ void gemm_phase(PG8_LAS unsigned char* lds, const Gemm g, const Sched& S, const Epi& E, unsigned long long* stamps) {
    const int tid = threadIdx.x, wid = __builtin_amdgcn_readfirstlane(tid >> 6), lane = tid & 63, wr = wid >> 2, wc = wid & 3, fr = lane & 15, fq = lane >> 4;
    const int K = g.K, nt = K / BK;
    int ts_lo = 0, ts_hi = 0, nts = 0; const unsigned long long rt_entry = STAMP ? (unsigned long long)wall_clock64() : 0ull;
#define PG8_STAMP() do { if (STAMP && wid == 0 && nts < 64) { const unsigned long long _c = (unsigned long long)clock64(); \
        ts_lo = (lane == nts) ? (int)(unsigned)_c : ts_lo; ts_hi = (lane == nts) ? (int)(unsigned)(_c >> 32) : ts_hi; ++nts; } } while (0)
    PG8_STAMP();
    unsigned voffA[2], voffB[2];
#pragma unroll
    for (int i = 0; i < 2; ++i) { int R, C; stage_rc(tid * 16 + i * 8192, R, C); const int Rb = Epi::PERM ? ((R & ~31) + perm32(R & 31)) : R;
        voffA[i] = (unsigned)(R * K + C) * 2u; voffB[i] = (unsigned)(Rb * K + C) * 2u; }
    const size_t kstep = (size_t)(BK * 2);
    const size_t hstep = (size_t)HALF * K * 2;
    const size_t tstep = 2 * hstep;
    const unsigned ldsw = (unsigned)wid * 1024u;
    const int aoff = lds_byte(wr * 64 + fr, fq * 8), boff = lds_byte(wc * 32 + fr, fq * 8);
#define PG8_SA(b, h) (((b) * 2 + (h)) * HTB)
#define PG8_SB(b, h) ((4 + (b) * 2 + (h)) * HTB)
#define PG8_STAGE(bufoff, gbase, voff) do { _Pragma("unroll") for (int _i = 0; _i < 2; ++_i) \
        __builtin_amdgcn_global_load_lds((const unsigned*)((const char*)(gbase) + (voff)[_i]), (PG8_LAS unsigned*)(lds + (bufoff) + ldsw + _i * 8192), 16, 0, 0); } while (0)
#define PG8_LDA(dst, b, h) do { _Pragma("unroll") for (int m = 0; m < 4; ++m) _Pragma("unroll") for (int k = 0; k < 2; ++k) dst[m][k] = *(const PG8_LAS bf16x8*)(lds + PG8_SA(b, h) + aoff + m * 2048 + k * 1024); } while (0)
#define PG8_LDB(dst, b, h) do { _Pragma("unroll") for (int n = 0; n < 2; ++n) _Pragma("unroll") for (int k = 0; k < 2; ++k) dst[n][k] = *(const PG8_LAS bf16x8*)(lds + PG8_SB(b, h) + boff + n * 2048 + k * 1024); } while (0)
#define PG8_MMA(ai, bj, At, Bt) do { __builtin_amdgcn_s_setprio(1); _Pragma("unroll") for (int m = 0; m < 4; ++m) _Pragma("unroll") for (int n = 0; n < 2; ++n) _Pragma("unroll") for (int k = 0; k < 2; ++k) \
        acc[ai][bj][m][n] = __builtin_amdgcn_mfma_f32_16x16x32_bf16(Bt[n][k], At[m][k], acc[ai][bj][m][n], 0, 0, 0); __builtin_amdgcn_s_setprio(0); } while (0)
#define PG8_WAIT_V(n) asm volatile("s_waitcnt vmcnt(" #n ")" ::: "memory")
#define PG8_WAIT_L(n) asm volatile("s_waitcnt lgkmcnt(" #n ")" ::: "memory")
#define PG8_BAR __builtin_amdgcn_s_barrier()
#define PG8_SCHED __builtin_amdgcn_sched_barrier(0)
    Unit cur, nxt; int ui = 0;
    if (!S.next(0, cur)) return;
    f32x4 acc[2][2][4][2];
#pragma unroll
    for (int a = 0; a < 2; ++a)
#pragma unroll
        for (int b = 0; b < 2; ++b)
#pragma unroll
            for (int m = 0; m < 4; ++m)
#pragma unroll
                for (int n = 0; n < 2; ++n) acc[a][b][m][n] = (f32x4){0.f, 0.f, 0.f, 0.f};
    bf16x8 At[4][2], B0[2][2], B1[2][2];
    const char* cA = (const char*)g.A + (size_t)cur.pm * tstep; const char* cB = (const char*)g.Bt + (size_t)cur.pn * tstep;
    S.a_ready(cur);
    PG8_STAGE(PG8_SB(0, 0), cB, voffB); PG8_STAGE(PG8_SA(0, 0), cA, voffA); PG8_STAGE(PG8_SB(0, 1), cB + hstep, voffB); PG8_STAGE(PG8_SA(0, 1), cA + hstep, voffA);
    if (wr == 1) PG8_BAR;
    PG8_WAIT_V(4); PG8_BAR;
    PG8_STAGE(PG8_SB(1, 0), cB + kstep, voffB); PG8_STAGE(PG8_SA(1, 0), cA + kstep, voffA); PG8_STAGE(PG8_SB(1, 1), cB + hstep + kstep, voffB);
    PG8_WAIT_V(6); PG8_BAR;
    PG8_STAMP();
    for (;;) {
        const bool has_next = S.next(ui + 1, nxt);
        const char* nA = has_next ? (const char*)g.A + (size_t)nxt.pm * tstep : cA; const char* nB = has_next ? (const char*)g.Bt + (size_t)nxt.pn * tstep : cB;
        for (int t = 0; t < nt; t += 2) {
            const bool last = (t == nt - 2);
            const char* a1 = cA + (size_t)(t + 1) * kstep;
            const char* a2 = last ? nA : cA + (size_t)(t + 2) * kstep; const char* b2 = last ? nB : cB + (size_t)(t + 2) * kstep;
            const char* a3 = a2 + kstep; const char* b3 = b2 + kstep;
            if (last && has_next) S.a_ready(nxt);
            PG8_LDB(B0, 0, 0); PG8_SCHED; PG8_LDA(At, 0, 0); PG8_STAGE(PG8_SA(1, 1), a1 + hstep, voffA);
            PG8_WAIT_L(8); PG8_BAR; PG8_WAIT_L(0); PG8_MMA(0, 0, At, B0); PG8_BAR; PG8_SCHED;
            PG8_LDB(B1, 0, 1); PG8_STAGE(PG8_SB(0, 0), b2, voffB);
            PG8_BAR; PG8_WAIT_L(0); PG8_MMA(0, 1, At, B1); PG8_BAR;
            PG8_LDA(At, 0, 1); PG8_STAGE(PG8_SA(0, 0), a2, voffA);
            PG8_BAR; PG8_WAIT_L(0); PG8_MMA(1, 0, At, B0); PG8_BAR; PG8_SCHED;
            PG8_STAGE(PG8_SB(0, 1), b2 + hstep, voffB);
            PG8_WAIT_V(6); PG8_BAR; PG8_MMA(1, 1, At, B1); PG8_BAR;
            PG8_LDB(B0, 1, 0); PG8_SCHED; PG8_LDA(At, 1, 0); PG8_STAGE(PG8_SA(0, 1), a2 + hstep, voffA);
            PG8_WAIT_L(8); PG8_BAR; PG8_WAIT_L(0); PG8_MMA(0, 0, At, B0); PG8_BAR; PG8_SCHED;
            PG8_LDB(B1, 1, 1); PG8_STAGE(PG8_SB(1, 0), b3, voffB);
            PG8_BAR; PG8_WAIT_L(0); PG8_MMA(0, 1, At, B1); PG8_BAR;
            PG8_LDA(At, 1, 1); PG8_STAGE(PG8_SA(1, 0), a3, voffA);
            PG8_BAR; PG8_WAIT_L(0); PG8_MMA(1, 0, At, B0); PG8_BAR; PG8_SCHED;
            PG8_STAGE(PG8_SB(1, 1), b3 + hstep, voffB);
            PG8_WAIT_V(6); PG8_BAR; PG8_MMA(1, 1, At, B1); PG8_BAR;
        }
        PG8_STAMP();
        if constexpr (!Epi::AFTER_DRAIN) { E(acc, cur, wr, wc, fr, fq); S.done(cur); }
        PG8_STAMP();
        if (!has_next) break;
        bool keep = false;
        if constexpr (has_keep_acc<Epi>::value) keep = E.keep_acc(cur);
        if (!keep) {
#pragma unroll
        for (int a = 0; a < 2; ++a)
#pragma unroll
            for (int b = 0; b < 2; ++b)
#pragma unroll
                for (int m = 0; m < 4; ++m)
#pragma unroll
                    for (int n = 0; n < 2; ++n) acc[a][b][m][n] = (f32x4){0.f, 0.f, 0.f, 0.f};
        }
        cur = nxt; cA = nA; cB = nB; ++ui;
    }
    PG8_WAIT_V(0);
    if (wr == 0) PG8_BAR;
    PG8_BAR;
    if constexpr (Epi::AFTER_DRAIN) { E.fused(acc, cur, wr, wc, fr, fq, lds, wid, lane); S.done(cur); }
    PG8_STAMP();
    if (STAMP && wid == 0) { stamps[lane] = lane < nts ? (((unsigned long long)(unsigned)ts_hi << 32) | (unsigned)ts_lo) : 0ull;
        if (lane == 62) stamps[62] = rt_entry; if (lane == 63) stamps[63] = (unsigned long long)wall_clock64(); }
#undef PG8_STAMP
#undef PG8_SA
#undef PG8_SB
#undef PG8_STAGE
#undef PG8_LDA
#undef PG8_LDB
#undef PG8_MMA
#undef PG8_WAIT_V
#undef PG8_WAIT_L
#undef PG8_BAR
#undef PG8_SCHED
}
}

using pg8::bf16_t; using pg8::bf16x8; using pg8::f32x4; using pg8::u32x4; using pg8::Unit;
typedef unsigned u32x2 __attribute__((ext_vector_type(2)));

constexpr int DM = 1024, NB = 4, SEQL = 4096, NTOK = NB * SEQL, CTXL = 256, NCTX = NB * CTXL, MROWS = NTOK + NCTX;
constexpr int DFF = 2816, INCOLS = 8224, NH = 8, HD = 128;
constexpr int OFF_Q = 2080, OFF_Z = 3104, OFF_U = 4128, OFF_AV = 5152, OFF_GA = 6176, OFF_GB = 7200;
constexpr float EPS = 1e-6f;
constexpr int LDS_BYTES = 159744;
constexpr int NPHASE = 16;
#ifndef SCAN16
#define SCAN16 1
#endif
#ifndef USE_CHUNKED
#define USE_CHUNKED 1
#endif

constexpr size_t MiB = 1048576;
constexpr size_t WS_W1T = 0, WS_WAT = 16 * MiB + MiB / 2, WS_WBT = WS_WAT + 2 * MiB, WS_WOT = WS_WBT + 2 * MiB, WS_WUPT = WS_WOT + 2 * MiB, WS_WDT = WS_WUPT + 11 * MiB;
constexpr size_t WS_MOD = 39 * MiB, WS_BA = 39 * MiB + MiB / 4, WS_BETA = 41 * MiB + MiB / 2, WS_G = 42 * MiB + 3 * MiB / 4;
constexpr size_t WS_A1 = 44 * MiB;
constexpr size_t WS_R1 = 78 * MiB;
constexpr size_t WS_QRAW = WS_R1 + 68 * MiB;
constexpr size_t WS_TT = 78 * MiB, WS_QG = 112 * MiB;
constexpr size_t WS_OF = 146 * MiB, WS_OB = 178 * MiB;
constexpr size_t WS_ZS = 78 * MiB, WS_GA = 110 * MiB, WS_GB = 210 * MiB;
constexpr size_t WS_AA = WS_A1;
constexpr size_t WS_T1 = 78 * MiB, WS_MG = 110 * MiB;
constexpr size_t WS_QN = 210 * MiB;
constexpr size_t WS_KNC = 242 * MiB, WS_VNC = 244 * MiB, WS_GC = 246 * MiB;
constexpr size_t WS_CTL = 248 * MiB;
constexpr size_t WS_XB = 248 * MiB + 65536;
constexpr size_t WS_END = 248 * MiB + 65536 + 262144;

typedef __bf16 bf16v2_t __attribute__((ext_vector_type(2)));
typedef float f32v2_t __attribute__((ext_vector_type(2)));
__device__ __forceinline__ unsigned cvt2(float a, float b) { f32v2_t v = {a, b}; bf16v2_t r = __builtin_convertvector(v, bf16v2_t); return __builtin_bit_cast(unsigned, r); }
__device__ __forceinline__ unsigned f2bf(float f) { return cvt2(f, f) & 0xffffu; }
__device__ __forceinline__ unsigned pk2(float lo, float hi) { return cvt2(lo, hi); }
__device__ __forceinline__ float bflo(unsigned w) { return __uint_as_float(w << 16); }
__device__ __forceinline__ float bfhi(unsigned w) { return __uint_as_float(w & 0xffff0000u); }
__device__ __forceinline__ float bf1(bf16_t b) { return __uint_as_float(((unsigned)b) << 16); }
__device__ __forceinline__ float sigmoidf_(float x) { return __builtin_amdgcn_rcpf(1.0f + __builtin_amdgcn_exp2f(-1.4426950408889634f * x)); }
__device__ __forceinline__ float siluf_(float x) { return x * sigmoidf_(x); }
__device__ __forceinline__ float geluf_(float x) { const float u = x * (2.3022082f + 0.10294324f * x * x); return x * __builtin_amdgcn_rcpf(1.0f + __builtin_amdgcn_exp2f(-u)); }
__device__ __forceinline__ float act_apply(float x, int act) { return act == 1 ? geluf_(x) : (act == 2 ? siluf_(x) : (act == 3 ? sigmoidf_(x) : x)); }
__device__ __forceinline__ float wave_sum(float v) {
#pragma unroll
    for (int o = 1; o < 64; o <<= 1) v += __shfl_xor(v, o);
    return v;
}
#define LDS_WAIT() asm volatile("s_waitcnt lgkmcnt(0)" ::: "memory")

struct EpiSel {
    static constexpr bool PERM = true, AFTER_DRAIN = false;
    bf16_t *O0, *O1, *O2, *O3, *O4; int ld0, ld1, ld2, ld3, ld4; int a0, a1, a2, a3, a4; int ba_pn; float* BA;
    __device__ __forceinline__ void operator()(const f32x4 (&acc)[2][2][4][2], const Unit& u, int wr, int wc, int fr, int fq) const {
        asm volatile("" : "+v"(fr), "+v"(fq));
        const int row0 = u.pm * 256 + wr * 64 + fr;
        if (u.pn == ba_pn) {
            if (wc == 0) {
#pragma unroll
                for (int ai = 0; ai < 2; ++ai)
#pragma unroll
                    for (int m = 0; m < 4; ++m) { float* rp = BA + (size_t)(row0 + ai * 128 + m * 16) * 32 + 8 * fq;
#pragma unroll
                        for (int n = 0; n < 2; ++n) *(f32x4*)(rp + 4 * n) = acc[ai][0][m][n]; }
            }
            return;
        }
        const int g = u.pn >> 2;
        bf16_t* O = g == 0 ? O0 : (g == 1 ? O1 : (g == 2 ? O2 : (g == 3 ? O3 : O4)));
        const int ldc = g == 0 ? ld0 : (g == 1 ? ld1 : (g == 2 ? ld2 : (g == 3 ? ld3 : ld4)));
        const int act = g == 0 ? a0 : (g == 1 ? a1 : (g == 2 ? a2 : (g == 3 ? a3 : a4)));
        const int col0 = (u.pn & 3) * 256 + wc * 32 + 8 * fq;
        bf16_t* Ob = O + (size_t)row0 * ldc + col0;
        if (act == 0) store_tile<0>(acc, Ob, ldc); else if (act == 1) store_tile<1>(acc, Ob, ldc); else if (act == 2) store_tile<2>(acc, Ob, ldc); else store_tile<3>(acc, Ob, ldc);
    }
    template <int ACT> __device__ __forceinline__ void store_tile(const f32x4 (&acc)[2][2][4][2], bf16_t* Ob, int ldc) const {
#pragma unroll
        for (int ai = 0; ai < 2; ++ai)
#pragma unroll
            for (int m = 0; m < 4; ++m) { bf16_t* rowp = Ob + (size_t)(ai * 128 + m * 16) * ldc;
#pragma unroll
                for (int bj = 0; bj < 2; ++bj) { f32x4 v0 = acc[ai][bj][m][0], v1 = acc[ai][bj][m][1];
                    if (ACT) {
#pragma unroll
                        for (int j = 0; j < 4; ++j) { float x0 = v0[j], x1 = v1[j];
                            if (ACT == 3) asm volatile("" : "+v"(x0), "+v"(x1));
                            v0[j] = ACT == 1 ? geluf_(x0) : (ACT == 2 ? siluf_(x0) : sigmoidf_(x0)); v1[j] = ACT == 1 ? geluf_(x1) : (ACT == 2 ? siluf_(x1) : sigmoidf_(x1)); } }
                    u32x4 w; w.x = pk2(v0[0], v0[1]); w.y = pk2(v0[2], v0[3]); w.z = pk2(v1[0], v1[1]); w.w = pk2(v1[2], v1[3]);
                    *(u32x4*)(rowp + bj * 128) = w; }
                __builtin_amdgcn_sched_barrier(0); }
    }
};
struct EpiGate {
    static constexpr bool PERM = true, AFTER_DRAIN = false;
    const bf16_t* G; const bf16_t* T; bf16_t* O;
    __device__ __forceinline__ void operator()(const f32x4 (&acc)[2][2][4][2], const Unit& u, int wr, int wc, int fr, int fq) const {
        asm volatile("" : "+v"(fr), "+v"(fq));
        const int row0 = u.pm * 256 + wr * 64 + fr, col0 = u.pn * 256 + wc * 32 + 8 * fq;
        const size_t off0 = (size_t)row0 * DM + col0;
        const u32x4 z4 = (u32x4){0u, 0u, 0u, 0u};
#pragma unroll
        for (int ai = 0; ai < 2; ++ai)
#pragma unroll
          for (int mp = 0; mp < 2; ++mp) {
            u32x4 gw[2][2], tw[2][2];
#pragma unroll
            for (int mm = 0; mm < 2; ++mm)
#pragma unroll
                for (int bj = 0; bj < 2; ++bj) { const size_t off = off0 + (size_t)(ai * 128 + (2 * mp + mm) * 16) * DM + bj * 128;
                    gw[mm][bj] = *(const u32x4*)(G + off); tw[mm][bj] = T ? *(const u32x4*)(T + off) : z4; }
#pragma unroll
            for (int mm = 0; mm < 2; ++mm)
#pragma unroll
                for (int bj = 0; bj < 2; ++bj) { const int m = 2 * mp + mm; const size_t off = off0 + (size_t)(ai * 128 + m * 16) * DM + bj * 128;
                    const f32x4 v0 = acc[ai][bj][m][0], v1 = acc[ai][bj][m][1]; const u32x4 g = gw[mm][bj], t = tw[mm][bj];
                    float r[8];
                    r[0] = v0[0] * bflo(g.x) + bflo(t.x); r[1] = v0[1] * bfhi(g.x) + bfhi(t.x); r[2] = v0[2] * bflo(g.y) + bflo(t.y); r[3] = v0[3] * bfhi(g.y) + bfhi(t.y);
                    r[4] = v1[0] * bflo(g.z) + bflo(t.z); r[5] = v1[1] * bfhi(g.z) + bfhi(t.z); r[6] = v1[2] * bflo(g.w) + bflo(t.w); r[7] = v1[3] * bfhi(g.w) + bfhi(t.w);
                    u32x4 w; w.x = pk2(r[0], r[1]); w.y = pk2(r[2], r[3]); w.z = pk2(r[4], r[5]); w.w = pk2(r[6], r[7]);
                    *(u32x4*)(O + off) = w; }
          }
    }
};
struct OrderAB {
    pg8::StaticOrder S0;
    __device__ bool next(int i, Unit& u) const { if (!S0.next(i >> 1, u)) return false; if (i & 1) { u.pm += 204; u.pn += 4; } return true; }
    __device__ __forceinline__ void a_ready(const Unit&) const {}
    __device__ __forceinline__ void done(const Unit&) const {}
};
struct EpiGateAB {
    static constexpr bool PERM = true, AFTER_DRAIN = false, KEEP_ACC = true;
    const bf16_t *GAp, *GBp; bf16_t* MGp;
    __device__ __forceinline__ bool keep_acc(const Unit& u) const { return u.pn < 4; }
    __device__ __forceinline__ void operator()(f32x4 (&acc)[2][2][4][2], const Unit& u, int wr, int wc, int fr, int fq) const {
        asm volatile("" : "+v"(fr), "+v"(fq));
        const bool first = u.pn < 4; const int pm = first ? u.pm : u.pm - 204, pn = first ? u.pn : u.pn - 4;
        const int row0 = pm * 256 + wr * 64 + fr, col0 = pn * 256 + wc * 32 + 8 * fq;
        const size_t off0 = (size_t)row0 * DM + col0;
#pragma unroll
        for (int ai = 0; ai < 2; ++ai)
#pragma unroll
          for (int mp = 0; mp < 2; ++mp) {
            u32x4 gb[2][2], ga[2][2];
#pragma unroll
            for (int mm = 0; mm < 2; ++mm)
#pragma unroll
                for (int bj = 0; bj < 2; ++bj) { const size_t off = off0 + (size_t)(ai * 128 + (2 * mp + mm) * 16) * DM + bj * 128;
                    gb[mm][bj] = *(const u32x4*)(GBp + off); ga[mm][bj] = first ? *(const u32x4*)(GAp + off) : (u32x4){0u, 0u, 0u, 0u}; }
#pragma unroll
            for (int mm = 0; mm < 2; ++mm)
#pragma unroll
                for (int bj = 0; bj < 2; ++bj) { const int m = 2 * mp + mm; const u32x4 b = gb[mm][bj], a = ga[mm][bj];
                    const float bv[8] = {bflo(b.x), bfhi(b.x), bflo(b.y), bfhi(b.y), bflo(b.z), bfhi(b.z), bflo(b.w), bfhi(b.w)};
                    if (first) {
                        const float av[8] = {bflo(a.x), bfhi(a.x), bflo(a.y), bfhi(a.y), bflo(a.z), bfhi(a.z), bflo(a.w), bfhi(a.w)};
#pragma unroll
                        for (int e = 0; e < 4; ++e) { acc[ai][bj][m][0][e] *= av[e] * __builtin_amdgcn_rcpf(bv[e]); acc[ai][bj][m][1][e] *= av[4 + e] * __builtin_amdgcn_rcpf(bv[4 + e]); }
                    } else {
                        const f32x4 v0 = acc[ai][bj][m][0], v1 = acc[ai][bj][m][1];
                        u32x4 w; w.x = pk2(v0[0] * bv[0], v0[1] * bv[1]); w.y = pk2(v0[2] * bv[2], v0[3] * bv[3]); w.z = pk2(v1[0] * bv[4], v1[1] * bv[5]); w.w = pk2(v1[2] * bv[6], v1[3] * bv[7]);
                        *(u32x4*)(MGp + off0 + (size_t)(ai * 128 + m * 16) * DM + bj * 128) = w; }
                }
          }
    }
};
struct EpiRes {
    static constexpr bool PERM = false, AFTER_DRAIN = false;
    const float* base; float* out; const float* gate;
    __device__ __forceinline__ void operator()(const f32x4 (&acc)[2][2][4][2], const Unit& u, int wr, int wc, int fr, int fq) const {
        asm volatile("" : "+v"(fr), "+v"(fq));
        const int row0 = u.pm * 256 + wr * 64 + fr, col0 = u.pn * 256 + wc * 32 + 4 * fq;
        const float* gp = gate + (size_t)(u.pm >> 4) * 6144 + col0;
        f32x4 gv[2][2];
#pragma unroll
        for (int bj = 0; bj < 2; ++bj)
#pragma unroll
            for (int n = 0; n < 2; ++n) gv[bj][n] = *(const f32x4*)(gp + bj * 128 + n * 16);
#pragma unroll
        for (int ai = 0; ai < 2; ++ai)
#pragma unroll
            for (int mp = 0; mp < 2; ++mp) {
                f32x4 bs[2][2][2];
#pragma unroll
                for (int mm = 0; mm < 2; ++mm)
#pragma unroll
                    for (int bj = 0; bj < 2; ++bj)
#pragma unroll
                        for (int n = 0; n < 2; ++n) bs[mm][bj][n] = *(const f32x4*)(base + (size_t)(row0 + ai * 128 + (2 * mp + mm) * 16) * DM + col0 + bj * 128 + n * 16);
#pragma unroll
                for (int mm = 0; mm < 2; ++mm)
#pragma unroll
                    for (int bj = 0; bj < 2; ++bj)
#pragma unroll
                        for (int n = 0; n < 2; ++n) *(f32x4*)(out + (size_t)(row0 + ai * 128 + (2 * mp + mm) * 16) * DM + col0 + bj * 128 + n * 16) = bs[mm][bj][n] + gv[bj][n] * acc[ai][bj][2 * mp + mm][n];
            }
    }
};
template <int MODE> struct EpiResNorm {
    static constexpr bool PERM = false, AFTER_DRAIN = true;
    const float* base; float* out; const float* gate; const float* ng; const float* mod; int sh_off, sc_off; bf16_t* hb; float* xbuf; unsigned* cnt;
    __device__ __forceinline__ void fused(f32x4 (&acc)[2][2][4][2], const Unit& u, int wr, int wc, int fr, int fq, PG8_LAS unsigned char* lds, int wid, int lane) const {
        asm volatile("" : "+v"(fr), "+v"(fq));
        PG8_LAS float* P = (PG8_LAS float*)lds;
        PG8_LAS float* Srs = (PG8_LAS float*)(lds + 8192);
        const int row0 = u.pm * 256 + wr * 64 + fr, col0 = u.pn * 256 + wc * 32 + 4 * fq;
        const float* gp = gate + (size_t)(u.pm >> 4) * 6144 + col0;
        f32x4 gv[2][2];
#pragma unroll
        for (int bj = 0; bj < 2; ++bj)
#pragma unroll
            for (int n = 0; n < 2; ++n) gv[bj][n] = *(const f32x4*)(gp + bj * 128 + n * 16);
#pragma unroll
        for (int ai = 0; ai < 2; ++ai)
#pragma unroll
            for (int mp = 0; mp < 2; ++mp) {
                f32x4 bs[2][2][2];
#pragma unroll
                for (int mm = 0; mm < 2; ++mm)
#pragma unroll
                    for (int bj = 0; bj < 2; ++bj)
#pragma unroll
                        for (int n = 0; n < 2; ++n) bs[mm][bj][n] = *(const f32x4*)(base + (size_t)(row0 + ai * 128 + (2 * mp + mm) * 16) * DM + col0 + bj * 128 + n * 16);
#pragma unroll
                for (int mm = 0; mm < 2; ++mm) { const int m = 2 * mp + mm; float ss = 0.f;
#pragma unroll
                    for (int bj = 0; bj < 2; ++bj)
#pragma unroll
                        for (int n = 0; n < 2; ++n) { const f32x4 x = bs[mm][bj][n] + gv[bj][n] * acc[ai][bj][m][n]; acc[ai][bj][m][n] = x;
                            if (MODE == 1) *(f32x4*)(out + (size_t)(row0 + ai * 128 + m * 16) * DM + col0 + bj * 128 + n * 16) = x;
                            ss += (x[0] * x[0] + x[1] * x[1]) + (x[2] * x[2] + x[3] * x[3]); }
                    ss += __shfl_xor(ss, 16); ss += __shfl_xor(ss, 32);
                    if (fq == 0) P[(ai * 128 + wr * 64 + m * 16 + fr) * 4 + wc] = ss; }
            }
        asm volatile("s_waitcnt lgkmcnt(0)" ::: "memory"); __builtin_amdgcn_s_barrier(); asm volatile("" ::: "memory");
        const int row = wid * 32 + (lane & 31);
        if (lane < 32) { const float t = (P[row * 4 + 0] + P[row * 4 + 1]) + (P[row * 4 + 2] + P[row * 4 + 3]);
            __hip_atomic_store(xbuf + ((size_t)(u.pm * 256 + row) * 4 + u.pn), t, __ATOMIC_RELAXED, __HIP_MEMORY_SCOPE_AGENT); }
        asm volatile("s_waitcnt vmcnt(0)" ::: "memory");
        if (lane == 0) __hip_atomic_fetch_add(cnt + 64 * u.pm, 1u, __ATOMIC_RELAXED, __HIP_MEMORY_SCOPE_AGENT);
        if (wid == 0) { unsigned sp = 0;
            while ((unsigned)__builtin_amdgcn_readfirstlane(__hip_atomic_load(cnt + 64 * u.pm, __ATOMIC_RELAXED, __HIP_MEMORY_SCOPE_AGENT)) < 32u) { __builtin_amdgcn_s_sleep(2); if (++sp > (1u << 24)) break; }
            __builtin_amdgcn_fence(__ATOMIC_ACQUIRE, "agent"); }
        asm volatile("s_waitcnt vmcnt(0) lgkmcnt(0)" ::: "memory"); __builtin_amdgcn_s_barrier(); asm volatile("" ::: "memory");
        if (lane < 32) { const float* sl = xbuf + (size_t)(u.pm * 256 + row) * 4; float t = 0.f;
#pragma unroll
            for (int q = 0; q < 4; ++q) t += __hip_atomic_load(sl + q, __ATOMIC_RELAXED, __HIP_MEMORY_SCOPE_AGENT);
            Srs[row] = 1.0f / sqrtf(t * (1.0f / DM) + EPS); }
        asm volatile("s_waitcnt vmcnt(0) lgkmcnt(0)" ::: "memory"); __builtin_amdgcn_s_barrier(); asm volatile("" ::: "memory");
        f32x4 gg[2][2], sh[2][2], sc[2][2];
#pragma unroll
        for (int bj = 0; bj < 2; ++bj)
#pragma unroll
            for (int n = 0; n < 2; ++n) { const int c = col0 + bj * 128 + n * 16; gg[bj][n] = *(const f32x4*)(ng + c);
                if (MODE == 1) { const float* mp_ = mod + (size_t)(u.pm >> 4) * 6144; sh[bj][n] = *(const f32x4*)(mp_ + sh_off + c); sc[bj][n] = *(const f32x4*)(mp_ + sc_off + c); } }
#pragma unroll
        for (int ai = 0; ai < 2; ++ai)
#pragma unroll
            for (int m = 0; m < 4; ++m) { const int rl = ai * 128 + wr * 64 + m * 16 + fr; const float rs = Srs[rl]; const size_t off = (size_t)(u.pm * 256 + rl) * DM + col0;
#pragma unroll
                for (int bj = 0; bj < 2; ++bj)
#pragma unroll
                    for (int n = 0; n < 2; ++n) { const f32x4 y = acc[ai][bj][m][n] * rs * gg[bj][n];
                        if (MODE == 0) *(f32x4*)(out + off + bj * 128 + n * 16) = y;
                        else { const f32x4 hv = y * (1.0f + sc[bj][n]) + sh[bj][n]; u32x2 w; w.x = pk2(hv[0], hv[1]); w.y = pk2(hv[2], hv[3]); *(u32x2*)(hb + off + bj * 128 + n * 16) = w; } } }
    }
};

struct EpiUp {
    static constexpr bool PERM = true, AFTER_DRAIN = false;
    const float* cw; const float* cb; bf16_t* ACT;
    __device__ __forceinline__ void operator()(const f32x4 (&acc)[2][2][4][2], const Unit& u, int wr, int wc, int fr, int fq) const {
        asm volatile("" : "+v"(fr), "+v"(fq));
        const int lane = (int)(threadIdx.x & 63);
        const int chb = u.pn * 128 + wc * 32 + 8 * fq;
        const int row0 = u.pm * 256 + wr * 64 + fr;
        f32x4 w0[2], w1[2], w2[2], bb[2];
#pragma unroll
        for (int n = 0; n < 2; ++n) { w0[n] = *(const f32x4*)(cw + chb + 4 * n); w1[n] = *(const f32x4*)(cw + DFF + chb + 4 * n); w2[n] = *(const f32x4*)(cw + 2 * DFF + chb + 4 * n); bb[n] = *(const f32x4*)(cb + chb + 4 * n); }
#pragma unroll
        for (int ai = 0; ai < 2; ++ai)
#pragma unroll
            for (int m = 0; m < 4; ++m) {
                float r[8];
#pragma unroll
                for (int n = 0; n < 2; ++n)
#pragma unroll
                    for (int e = 0; e < 4; ++e) {
                        const float cur = acc[ai][0][m][n][e];
                        const float pv_same = __int_as_float(__builtin_amdgcn_update_dpp(0, __float_as_int(cur), 0x111, 0xf, 0xf, true));
                        const float pv_wrap = (m > 0) ? __int_as_float(__builtin_amdgcn_update_dpp(0, __float_as_int(acc[ai][0][m > 0 ? m - 1 : 0][n][e]), 0x121, 0xf, 0xf, true)) : 0.f;
                        const float nx_same = __int_as_float(__builtin_amdgcn_update_dpp(0, __float_as_int(cur), 0x101, 0xf, 0xf, true));
                        const float nx_wrap = (m < 3) ? __int_as_float(__builtin_amdgcn_update_dpp(0, __float_as_int(acc[ai][0][m < 3 ? m + 1 : 3][n][e]), 0x12F, 0xf, 0xf, true)) : 0.f;
                        const float prev = fr > 0 ? pv_same : pv_wrap;
                        const float next = fr < 15 ? nx_same : nx_wrap;
                        const float a = w0[n][e] * prev + w1[n][e] * cur + w2[n][e] * next + bb[n][e];
                        r[n * 4 + e] = geluf_(a) * acc[ai][1][m][n][e];
                    }
                u32x4 w; w.x = pk2(r[0], r[1]); w.y = pk2(r[2], r[3]); w.z = pk2(r[4], r[5]); w.w = pk2(r[6], r[7]);
                *(u32x4*)(ACT + (size_t)(row0 + ai * 128 + m * 16) * DFF + chb) = w;
            }
    }
};

struct Order1a {
    int G, c;
    __device__ bool next(int i, Unit& u) const {
        const int L = i * G + c;
        if (L < 64 * 13) { const int grp = L / 104, r = L % 104; u.pm = grp * 8 + (r & 7); u.pn = r >> 3; return true; }
        const int r = L - 64 * 13; if (r >= 36) return false;
        u.pm = 64 + (r & 3); const int q = r >> 2; u.pn = q < 8 ? q : 12; return true;
    }
    __device__ __forceinline__ void a_ready(const Unit&) const {}
    __device__ __forceinline__ void done(const Unit&) const {}
};

struct Args { const float* in[25]; float* out; unsigned char* ws; int ph_lo, ph_hi, coop, pad; };

__device__ __forceinline__ void transpose_item(const float* __restrict__ W, int N, int srccol0, int k0, bf16_t* WT, int K, int drow0, float* scr, int lane) {
    if (srccol0 >= 0) {
        float tv[32];
#pragma unroll
        for (int i = 0; i < 32; ++i) { const int kk = 2 * i + (lane >> 5); tv[i] = W[(size_t)(k0 + kk) * N + srccol0 + (lane & 31)]; }
#pragma unroll
        for (int i = 0; i < 32; ++i) { const int kk = 2 * i + (lane >> 5); scr[kk * 33 + (lane & 31)] = tv[i]; }
    } else {
#pragma unroll 8
        for (int i = 0; i < 32; ++i) { const int kk = 2 * i + (lane >> 5); scr[kk * 33 + (lane & 31)] = 0.f; }
    }
    LDS_WAIT();
    const int c = lane & 7;
#pragma unroll
    for (int j = 0; j < 4; ++j) { const int n = (lane >> 3) + 8 * j; const float* s = scr + (8 * c) * 33 + n;
        u32x4 o; o.x = pk2(s[0 * 33], s[1 * 33]); o.y = pk2(s[2 * 33], s[3 * 33]); o.z = pk2(s[4 * 33], s[5 * 33]); o.w = pk2(s[6 * 33], s[7 * 33]);
        *(u32x4*)(WT + (size_t)(drow0 + n) * K + k0 + 8 * c) = o; }
    LDS_WAIT();
}

__device__ __forceinline__ int w1t_srccol(int nb) {
    if (nb < 64) return nb * 32;
    if (nb < 96) return OFF_Q + (nb - 64) * 32;
    if (nb == 96) return 2048;
    if (nb < 104) return -1;
    if (nb < 136) return OFF_U + (nb - 104) * 32;
    if (nb < 168) return OFF_AV + (nb - 136) * 32;
    if (nb < 200) return OFF_Z + (nb - 168) * 32;
    if (nb < 232) return OFF_GA + (nb - 200) * 32;
    return OFF_GB + (nb - 232) * 32;
}

__device__ __forceinline__ void phase0(const Args& a, unsigned char* shm, int gw, int NGW, int wave, int lane, int tid) {
    unsigned char* ws = a.ws;
    float* scr = (float*)(shm + wave * 16384);
    constexpr int I1 = 264 * 16, IA = 32 * 16, IU = 176 * 16, ID = 32 * 44;
    constexpr int NIT = I1 + 3 * IA + IU + ID;
    for (int it = gw; it < NIT; it += NGW) {
        int r = it;
        if (r < I1) { const int nb = r >> 4, kb = r & 15; transpose_item(a.in[7], INCOLS, w1t_srccol(nb), kb * 64, (bf16_t*)(ws + WS_W1T), DM, nb * 32, scr, lane); continue; } r -= I1;
        if (r < IA) { const int nb = r >> 4, kb = r & 15; transpose_item(a.in[17], DM, nb * 32, kb * 64, (bf16_t*)(ws + WS_WAT), DM, nb * 32, scr, lane); continue; } r -= IA;
        if (r < IA) { const int nb = r >> 4, kb = r & 15; transpose_item(a.in[12], DM, nb * 32, kb * 64, (bf16_t*)(ws + WS_WBT), DM, nb * 32, scr, lane); continue; } r -= IA;
        if (r < IA) { const int nb = r >> 4, kb = r & 15; transpose_item(a.in[18], DM, nb * 32, kb * 64, (bf16_t*)(ws + WS_WOT), DM, nb * 32, scr, lane); continue; } r -= IA;
        if (r < IU) { const int nb = r >> 4, kb = r & 15; const int j = nb >> 3, wi = nb & 7; const int sc = wi < 4 ? (128 * j + 32 * wi) : (DFF + 128 * j + 32 * (wi - 4));
            transpose_item(a.in[20], 2 * DFF, sc, kb * 64, (bf16_t*)(ws + WS_WUPT), DM, nb * 32, scr, lane); continue; } r -= IU;
        { const int nb = r / 44, kb = r % 44; transpose_item(a.in[23], DM, nb * 32, kb * 64, (bf16_t*)(ws + WS_WDT), DFF, nb * 32, scr, lane); }
    }
    __syncthreads();
    float* red = (float*)shm;
    float* sil = (float*)(shm + 16384);
    const float* wm = a.in[4]; const float* bm = a.in[5]; const float* cin = a.in[1]; const float* cctx = a.in[3];
    float* MOD = (float*)(ws + WS_MOD);
    if ((int)blockIdx.x < 192) {
        for (int i = tid; i < 5 * 1024; i += 512) { const float cv = i < 4096 ? cin[i] : cctx[i - 4096]; sil[i] = siluf_(cv); }
    }
    __syncthreads();
    for (int it = blockIdx.x; it < 192; it += gridDim.x) {
        const int c = tid & 31, kq = tid >> 5, col0 = it * 32;
        float s0 = 0.f, s1 = 0.f, s2 = 0.f, s3 = 0.f, s4 = 0.f;
#pragma unroll 16
        for (int kk = 0; kk < 64; ++kk) { const int k = kq * 64 + kk; const float w = wm[(size_t)k * 6144 + col0 + c];
            s0 += sil[k] * w; s1 += sil[1024 + k] * w; s2 += sil[2048 + k] * w; s3 += sil[3072 + k] * w; s4 += sil[4096 + k] * w; }
        red[(kq * 5 + 0) * 32 + c] = s0; red[(kq * 5 + 1) * 32 + c] = s1; red[(kq * 5 + 2) * 32 + c] = s2; red[(kq * 5 + 3) * 32 + c] = s3; red[(kq * 5 + 4) * 32 + c] = s4;
        __syncthreads();
        if (tid < 160) { const int b = tid >> 5, cc = tid & 31; float sv = 0.f;
            for (int q = 0; q < 16; ++q) sv += red[(q * 5 + b) * 32 + cc];
            MOD[b * 6144 + col0 + cc] = sv + bm[col0 + cc]; }
        __syncthreads();
    }
}

__device__ __forceinline__ void norm_mod_rows(const float* X, int nx, const float* X2, int n2, const float* g, const float* MOD, int sh_off, int sc_off, bf16_t* out, int gw, int NGW, int lane) {
    for (int r0 = gw; r0 < nx + n2; r0 += 2 * NGW) {
        const int r1 = r0 + NGW; const bool has1 = r1 < nx + n2; const int rr[2] = {r0, has1 ? r1 : r0};
        f32x4 v[2][4]; float ss[2];
#pragma unroll
        for (int u = 0; u < 2; ++u) { const int r = rr[u]; const float* src = r < nx ? X + (size_t)r * DM : X2 + (size_t)(r - nx) * DM;
#pragma unroll
            for (int j = 0; j < 4; ++j) v[u][j] = *(const f32x4*)(src + 4 * lane + 256 * j); }
#pragma unroll
        for (int u = 0; u < 2; ++u) { float s_ = 0.f;
#pragma unroll
            for (int j = 0; j < 4; ++j) s_ += (v[u][j][0] * v[u][j][0] + v[u][j][1] * v[u][j][1]) + (v[u][j][2] * v[u][j][2] + v[u][j][3] * v[u][j][3]);
            ss[u] = wave_sum(s_); }
#pragma unroll
        for (int u = 0; u < 2; ++u) { if (u == 1 && !has1) break;
            const int r = rr[u]; const int mb = r < nx ? (r >> 12) : 4;
            const float rs = 1.0f / sqrtf(ss[u] * (1.0f / DM) + EPS);
            const float* mp = MOD + (size_t)mb * 6144;
#pragma unroll
            for (int j = 0; j < 4; ++j) { const int col = 4 * lane + 256 * j;
                const f32x4 gg = *(const f32x4*)(g + col), sh = *(const f32x4*)(mp + sh_off + col), sc = *(const f32x4*)(mp + sc_off + col);
                const f32x4 y = v[u][j] * rs * gg; const f32x4 h = y * (1.0f + sc) + sh;
                u32x2 w; w.x = pk2(h[0], h[1]); w.y = pk2(h[2], h[3]);
                *(u32x2*)(out + (size_t)r * DM + col) = w; } }
    }
}

__device__ __forceinline__ void phase_branch_a(const Args& a, unsigned char* shm, const bf16_t* UG, const bf16_t* VG, bf16_t* AA, int wave, int lane, int tid) {
    bf16_t* VnT = (bf16_t*)shm;
    bf16_t* WsL = VnT + 128 * 136;
    float* stat = (float*)(shm + 2 * 128 * 136 * 2);
    const float* ln_g = a.in[13]; const float* ln_b = a.in[14]; const float* a_ws = a.in[15]; const float* a_bs = a.in[16];
    for (int it = blockIdx.x; it < 256; it += gridDim.x) {
        const int chunk = it >> 1, gh = it & 1, tok0 = chunk * 128;
        for (int tt = 0; tt < 16; ++tt) { const int t = wave * 16 + tt; const bf16_t* row = VG + (size_t)(tok0 + t) * DM + lane * 16;
            const u32x4 p0 = *(const u32x4*)row, p1 = *(const u32x4*)(row + 8);
            const unsigned w8[8] = {p0.x, p0.y, p0.z, p0.w, p1.x, p1.y, p1.z, p1.w};
            float s = 0.f, q = 0.f;
#pragma unroll
            for (int e = 0; e < 8; ++e) { const float x0 = bflo(w8[e]), x1 = bfhi(w8[e]); s += x0 + x1; q += x0 * x0 + x1 * x1; }
            s = wave_sum(s); q = wave_sum(q);
            const float mean = s * (1.0f / DM); const float var = q * (1.0f / DM) - mean * mean;
            if (lane == 0) { stat[2 * t] = mean; stat[2 * t + 1] = 1.0f / sqrtf(fmaxf(var, 0.f) + EPS); }
        }
        __syncthreads();
        for (int gi = 0; gi < 4; ++gi) {
            const int g = gh * 4 + gi;
            { const int j = tid >> 2, cq = (tid & 3) * 32; const float mean = stat[2 * j], rstd = stat[2 * j + 1];
              const bf16_t* src = VG + (size_t)(tok0 + j) * DM + g * 128 + cq;
#pragma unroll
              for (int v4 = 0; v4 < 4; ++v4) { const u32x4 p = *(const u32x4*)(src + 8 * v4); const unsigned w4[4] = {p.x, p.y, p.z, p.w};
#pragma unroll
                  for (int e = 0; e < 4; ++e) { const int cl = cq + 8 * v4 + 2 * e; const int ch = g * 128 + cl;
                      const float y0 = (bflo(w4[e]) - mean) * rstd * ln_g[ch] + ln_b[ch], y1 = (bfhi(w4[e]) - mean) * rstd * ln_g[ch + 1] + ln_b[ch + 1];
                      VnT[cl * 136 + j] = (bf16_t)f2bf(y0); VnT[(cl + 1) * 136 + j] = (bf16_t)f2bf(y1); } }
              const int i = tid >> 2, jq = (tid & 3) * 32; const float* wsrc = a_ws + ((size_t)g * 128 + i) * 128 + jq;
#pragma unroll
              for (int v4 = 0; v4 < 4; ++v4) { const f32x4 x0 = *(const f32x4*)(wsrc + 8 * v4), x1 = *(const f32x4*)(wsrc + 8 * v4 + 4);
                  u32x4 o; o.x = pk2(x0[0], x0[1]); o.y = pk2(x0[2], x0[3]); o.z = pk2(x1[0], x1[1]); o.w = pk2(x1[2], x1[3]);
                  *(u32x4*)(WsL + i * 136 + jq + 8 * v4) = o; }
            }
            __syncthreads();
            const int cb = (wave >> 1) * 32, ib = (wave & 1) * 64, lr = lane & 15, lq = lane >> 4;
            f32x4 acc[2][4];
#pragma unroll
            for (int m = 0; m < 2; ++m)
#pragma unroll
                for (int n = 0; n < 4; ++n) acc[m][n] = (f32x4){0.f, 0.f, 0.f, 0.f};
#pragma unroll
            for (int ks = 0; ks < 4; ++ks) { bf16x8 af[2], bfr[4];
#pragma unroll
                for (int m = 0; m < 2; ++m) af[m] = *(const bf16x8*)(VnT + (cb + 16 * m + lr) * 136 + ks * 32 + 8 * lq);
#pragma unroll
                for (int n = 0; n < 4; ++n) bfr[n] = *(const bf16x8*)(WsL + (ib + 16 * n + lr) * 136 + ks * 32 + 8 * lq);
#pragma unroll
                for (int m = 0; m < 2; ++m)
#pragma unroll
                    for (int n = 0; n < 4; ++n) acc[m][n] = __builtin_amdgcn_mfma_f32_16x16x32_bf16(af[m], bfr[n], acc[m][n], 0, 0, 0); }
#pragma unroll
            for (int m = 0; m < 2; ++m)
#pragma unroll
                for (int n = 0; n < 4; ++n) { const int i = ib + 16 * n + lr; const float bs = a_bs[g * 128 + i]; const int ch = g * 128 + cb + 16 * m + lq * 4;
                    const size_t off = (size_t)(tok0 + i) * DM + ch;
                    const u32x2 uw = *(const u32x2*)(UG + off);
                    u32x2 o; o.x = pk2(bflo(uw.x) * (acc[m][n][0] + bs), bfhi(uw.x) * (acc[m][n][1] + bs)); o.y = pk2(bflo(uw.y) * (acc[m][n][2] + bs), bfhi(uw.y) * (acc[m][n][3] + bs));
                    *(u32x2*)(AA + off) = o; }
            __syncthreads();
        }
    }
}

__device__ __forceinline__ void conv_emit(const u32x4 pv, const u32x4 cv, const u32x4 nv, const float* wp, int typ, bf16_t* dst) {
    const unsigned pu[4] = {pv.x, pv.y, pv.z, pv.w}, cu[4] = {cv.x, cv.y, cv.z, cv.w}, nu[4] = {nv.x, nv.y, nv.z, nv.w};
    float y[8]; float ss = 0.f;
#pragma unroll
    for (int e = 0; e < 4; ++e) {
        const float w00 = wp[2 * e], w01 = wp[2 * e + 1], w10 = wp[3072 + 2 * e], w11 = wp[3072 + 2 * e + 1], w20 = wp[6144 + 2 * e], w21 = wp[6144 + 2 * e + 1];
        const float a0 = w00 * bflo(pu[e]) + w10 * bflo(cu[e]) + w20 * bflo(nu[e]), a1 = w01 * bfhi(pu[e]) + w11 * bfhi(cu[e]) + w21 * bfhi(nu[e]);
        y[2 * e] = siluf_(a0); y[2 * e + 1] = siluf_(a1); ss += y[2 * e] * y[2 * e] + y[2 * e + 1] * y[2 * e + 1]; }
    if (typ != 1) { ss += __shfl_xor(ss, 1); ss += __shfl_xor(ss, 2); ss += __shfl_xor(ss, 4); ss += __shfl_xor(ss, 8);
        const float sc = (1.0f / sqrtf(ss + EPS)) * (typ == 2 ? 0.08838834764831845f : 1.0f);
#pragma unroll
        for (int e = 0; e < 8; ++e) y[e] *= sc; }
    u32x4 o; o.x = pk2(y[0], y[1]); o.y = pk2(y[2], y[3]); o.z = pk2(y[4], y[5]); o.w = pk2(y[6], y[7]);
    *(u32x4*)dst = o;
}
__device__ __forceinline__ void phase_conv_prep(const Args& a, const bf16_t* KV, const bf16_t* QR, const float* BA, bf16_t* KNx, bf16_t* VNx, bf16_t* KNc, bf16_t* VNc, bf16_t* QN, float* BETA, float* GG, int gw, int NGW, int lane) {
    const float* cw = a.in[8];
    const u32x4 z4 = (u32x4){0u, 0u, 0u, 0u};
    for (int it = gw; it < 2048; it += NGW) {
        const int blk = it >> 1, ch0 = (it & 1) * 512 + lane * 8, r0 = blk * 17;
        u32x4 W[3][3];
        auto row_ptr = [&](int typ, int r) -> const bf16_t* { return typ < 2 ? KV + (size_t)r * 2048 + typ * 1024 + ch0 : QR + (size_t)(r < NTOK ? r : 0) * 1024 + ch0; };
        auto seq_t = [&](int r) -> int { return r < NTOK ? (r & (SEQL - 1)) : ((r - NTOK) & (CTXL - 1)); };
        auto seq_L = [&](int r) -> int { return r < NTOK ? SEQL : CTXL; };
        {   const int t = seq_t(r0);
#pragma unroll
            for (int typ = 0; typ < 3; ++typ) { W[typ][0] = t > 0 ? *(const u32x4*)row_ptr(typ, r0 - 1) : z4; W[typ][1] = *(const u32x4*)row_ptr(typ, r0); }
        }
#pragma unroll 1
        for (int rr = 0; rr < 17; ++rr) { const int r = r0 + rr; const bool isx = r < NTOK; const int t = seq_t(r); const bool hasn = t < seq_L(r) - 1;
            const bool hasp = t > 0;
#pragma unroll
            for (int typ = 0; typ < 3; ++typ) W[typ][2] = (r + 1 < MROWS) ? *(const u32x4*)row_ptr(typ, r + 1) : z4;
#pragma unroll
            for (int typ = 0; typ < 3; ++typ) {
                if (typ == 2 && !isx) break;
                bf16_t* dst = typ == 0 ? (isx ? KNx + (size_t)r * DM : KNc + (size_t)(r - NTOK) * DM) : (typ == 1 ? (isx ? VNx + (size_t)r * DM : VNc + (size_t)(r - NTOK) * DM) : QN + (size_t)r * DM);
                conv_emit(hasp ? W[typ][0] : z4, W[typ][1], hasn ? W[typ][2] : z4, cw + typ * 1024 + ch0, typ, dst + ch0);
            }
            if ((it & 1) == 0 && lane < 16) { const int dir = lane >> 3, h = lane & 7;
                const float bl = BA[(size_t)r * 32 + dir * 8 + h], al = BA[(size_t)r * 32 + 16 + dir * 8 + h] + a.in[10][dir * 8 + h];
                const float sp = fmaxf(al, 0.f) + log1pf(__expf(-fabsf(al)));
                BETA[((size_t)dir * MROWS + r) * 8 + h] = sigmoidf_(bl);
                GG[((size_t)dir * MROWS + r) * 8 + h] = -__expf(a.in[9][dir * 8 + h]) * sp; }
#pragma unroll
            for (int typ = 0; typ < 3; ++typ) { W[typ][0] = W[typ][1]; W[typ][1] = W[typ][2]; }
        }
    }
}

__device__ __forceinline__ float row_allsum16(float x) {
    x += __int_as_float(__builtin_amdgcn_update_dpp(0, __float_as_int(x), 0x128, 0xf, 0xf, false));
    x += __int_as_float(__builtin_amdgcn_update_dpp(0, __float_as_int(x), 0x124, 0xf, 0xf, false));
    x += __int_as_float(__builtin_amdgcn_update_dpp(0, __float_as_int(x), 0x122, 0xf, 0xf, false));
    x += __int_as_float(__builtin_amdgcn_update_dpp(0, __float_as_int(x), 0x121, 0xf, 0xf, false));
    return x;
}
struct ScanBlk { u32x4 k[8], q[8]; bf16_t v[8]; float be[8], g[8]; };
__device__ __forceinline__ void scan_load(ScanBlk& B, const bf16_t* Kb, const bf16_t* Vb, const bf16_t* Qb, const float* BE, const float* GP, int s0, int n, int dir, int seg, int kk, int dvc, int h) {
#pragma unroll
    for (int j = 0; j < 8; ++j) { int s = s0 + j; s = s < n ? s : n - 1; const int t = dir ? n - 1 - s : s;
        B.k[j] = *(const u32x4*)(Kb + (size_t)t * DM + kk * 8);
        B.q[j] = seg ? *(const u32x4*)(Qb + (size_t)t * DM + kk * 8) : (u32x4){0u, 0u, 0u, 0u};
        B.v[j] = Vb[(size_t)t * DM + dvc];
        B.be[j] = BE[(size_t)t * 8 + h]; B.g[j] = GP[(size_t)t * 8 + h]; }
}
__device__ __forceinline__ void scan_compute(const ScanBlk& B, float (&S)[8], bf16_t* Ob, int s0, int n, int dir, int seg, int kk, int dvc) {
#pragma unroll
    for (int j = 0; j < 8; ++j) { const int s = s0 + j; const int t = dir ? n - 1 - s : s;
        const float e = __expf(B.g[j]);
        const float kf[8] = {bflo(B.k[j].x), bfhi(B.k[j].x), bflo(B.k[j].y), bfhi(B.k[j].y), bflo(B.k[j].z), bfhi(B.k[j].z), bflo(B.k[j].w), bfhi(B.k[j].w)};
        float p0 = kf[0] * S[0], p1 = kf[1] * S[1];
#pragma unroll
        for (int i = 2; i < 8; i += 2) { p0 += kf[i] * S[i]; p1 += kf[i + 1] * S[i + 1]; }
        const float part = row_allsum16(p0 + p1);
        const float delta = B.be[j] * (bf1(B.v[j]) - e * part);
#pragma unroll
        for (int i = 0; i < 8; ++i) S[i] = e * S[i] + kf[i] * delta;
        if (seg) {
            const float qf[8] = {bflo(B.q[j].x), bfhi(B.q[j].x), bflo(B.q[j].y), bfhi(B.q[j].y), bflo(B.q[j].z), bfhi(B.q[j].z), bflo(B.q[j].w), bfhi(B.q[j].w)};
            float q0 = qf[0] * S[0], q1 = qf[1] * S[1];
#pragma unroll
            for (int i = 2; i < 8; i += 2) { q0 += qf[i] * S[i]; q1 += qf[i + 1] * S[i + 1]; }
            const float po = row_allsum16(q0 + q1);
            if (kk == 0) Ob[(size_t)t * DM + dvc] = (bf16_t)f2bf(po);
        }
    }
}
__device__ __forceinline__ void phase_scan(const bf16_t* KNx, const bf16_t* VNx, const bf16_t* KNc, const bf16_t* VNc, const bf16_t* QN, const float* BETA, const float* GG, bf16_t* OF, bf16_t* OB, int gw, int NGW, int lane) {
    for (int it = gw; it < 2048; it += NGW) {
        const int sl = it & 31, h = (it >> 5) & 7, b = (it >> 8) & 3, dir = it >> 10;
        const int kk = lane & 15, c = lane >> 4, dvc = sl * 4 + c;
        float S[8];
#pragma unroll
        for (int i = 0; i < 8; ++i) S[i] = 0.f;
        bf16_t* Ob = (dir ? OB : OF) + (size_t)b * SEQL * DM + h * 128;
        for (int seg = 0; seg < 2; ++seg) {
            const int n = seg ? SEQL : CTXL;
            const bf16_t* Kb = (seg ? KNx + (size_t)b * SEQL * DM : KNc + (size_t)b * CTXL * DM) + h * 128;
            const bf16_t* Vb = (seg ? VNx + (size_t)b * SEQL * DM : VNc + (size_t)b * CTXL * DM) + h * 128;
            const bf16_t* Qb = QN + (size_t)b * SEQL * DM + h * 128;
            const size_t rb = (size_t)dir * MROWS + (seg ? b * SEQL : NTOK + b * CTXL);
            const float* BE = BETA + rb * 8; const float* GP = GG + rb * 8;
            ScanBlk A, B;
            scan_load(A, Kb, Vb, Qb, BE, GP, 0, n, dir, seg, kk, dvc, h);
            for (int s0 = 0; s0 < n; s0 += 16) {
                scan_load(B, Kb, Vb, Qb, BE, GP, s0 + 8, n, dir, seg, kk, dvc, h);
                scan_compute(A, S, Ob, s0, n, dir, seg, kk, dvc);
                scan_load(A, Kb, Vb, Qb, BE, GP, s0 + 16, n, dir, seg, kk, dvc, h);
                scan_compute(B, S, Ob, s0 + 8, n, dir, seg, kk, dvc);
            }
        }
    }
}

typedef float f32x16 __attribute__((ext_vector_type(16)));
#define MFMA32(a, b, c) __builtin_amdgcn_mfma_f32_32x32x16_bf16((a), (b), (c), 0, 0, 0)
__device__ __forceinline__ int crow(int reg, int h) { return (reg & 3) + 8 * (reg >> 2) + 4 * h; }
__device__ __forceinline__ bf16x8 pack8(const f32x16& x, int s) {
    u32x4 p; p.x = cvt2(x[8 * s], x[8 * s + 1]); p.y = cvt2(x[8 * s + 2], x[8 * s + 3]); p.z = cvt2(x[8 * s + 4], x[8 * s + 5]); p.w = cvt2(x[8 * s + 6], x[8 * s + 7]);
    return __builtin_bit_cast(bf16x8, p);
}
__device__ __forceinline__ f32x16 zero16() { f32x16 z;
#pragma unroll
    for (int i = 0; i < 16; ++i) z[i] = 0.f;
    return z; }
constexpr int NCH = 68;
constexpr int PREP_LDS = 64 * 68 * 4 + 512;

__device__ __forceinline__ void phase_chunk_prep(unsigned char* shm, const bf16_t* KNx, const bf16_t* KNc, const bf16_t* QN, const float* BETA, const float* GG, bf16_t* TT, bf16_t* QG, float* GC, int gw, int NGW, int wave, int lane) {
    float* Am = (float*)(shm + wave * PREP_LDS);
    float* gcl = Am + 64 * 68; float* bl = gcl + 64;
    for (int qi = gw; qi < 64 * NCH; qi += NGW) {
        const int it = qi < 256 ? (qi >> 2) * NCH + (qi & 3) : ((qi - 256) >> 6) * NCH + 4 + ((qi - 256) & 63);
        int r = lane & 31, hh = lane >> 5; asm volatile("" : "+v"(r), "+v"(hh));
        const int cidx = it % NCH, sc = it / NCH, h = sc & 7, b = (sc >> 3) & 3, dir = sc >> 5;
        const bool isx = cidx >= 4; const int cl = isx ? cidx - 4 : cidx, Ls = isx ? SEQL : CTXL;
        const int t0 = dir ? Ls - 1 - cl * 64 : cl * 64, ts = dir ? -1 : 1;
        const bf16_t* Kp = (isx ? KNx + (size_t)b * SEQL * DM : KNc + (size_t)b * CTXL * DM) + h * 128;
        const bf16_t* Qp = QN + (size_t)b * SEQL * DM + h * 128;
        const size_t rowbase = (size_t)dir * MROWS + (isx ? b * SEQL : NTOK + b * CTXL);
        { const int t = t0 + ts * lane; float g = GG[(rowbase + t) * 8 + h]; const float be = BETA[(rowbase + t) * 8 + h];
#pragma unroll
          for (int o = 1; o < 64; o <<= 1) { const float v = __shfl_up(g, o); if (lane >= o) g += v; }
          gcl[lane] = g; bl[lane] = be; GC[(size_t)it * 64 + lane] = g; }
        LDS_WAIT();
        bf16x8 kf[2][8];
#pragma unroll
        for (int ti = 0; ti < 2; ++ti)
#pragma unroll
            for (int s = 0; s < 8; ++s) kf[ti][s] = *(const bf16x8*)(Kp + (size_t)(t0 + ts * (32 * ti + r)) * DM + 16 * s + 8 * hh);
        f32x16 d00 = zero16(), d10 = zero16(), d11 = zero16();
#pragma unroll
        for (int s = 0; s < 8; ++s) { d00 = MFMA32(kf[0][s], kf[0][s], d00); d10 = MFMA32(kf[1][s], kf[0][s], d10); d11 = MFMA32(kf[1][s], kf[1][s], d11); }
        __builtin_amdgcn_sched_barrier(0);
        const float gcj0 = gcl[r], gcj1 = gcl[32 + r];
#pragma unroll
        for (int rho = 0; rho < 16; ++rho) { const int i0 = crow(rho, hh), i1 = 32 + i0;
            { const float gi = gcl[i0], bi = bl[i0]; Am[i0 * 68 + r] = (i0 > r) ? bi * d00[rho] * __expf(fminf(gi - gcj0, 0.f)) : 0.f; }
            { const float gi = gcl[i1], bi = bl[i1]; Am[i1 * 68 + r] = bi * d10[rho] * __expf(fminf(gi - gcj0, 0.f));
              Am[i1 * 68 + 32 + r] = (i1 > 32 + r) ? bi * d11[rho] * __expf(fminf(gi - gcj1, 0.f)) : 0.f; } }
        LDS_WAIT();
        __builtin_amdgcn_sched_barrier(0);
        if (isx) {
            bf16x8 qf[2][8];
#pragma unroll
            for (int ti = 0; ti < 2; ++ti)
#pragma unroll
                for (int s = 0; s < 8; ++s) qf[ti][s] = *(const bf16x8*)(Qp + (size_t)(t0 + ts * (32 * ti + r)) * DM + 16 * s + 8 * hh);
            f32x16 e00 = zero16(), e10 = zero16(), e11 = zero16();
#pragma unroll
            for (int s = 0; s < 8; ++s) { e00 = MFMA32(qf[0][s], kf[0][s], e00); e10 = MFMA32(qf[1][s], kf[0][s], e10); e11 = MFMA32(qf[1][s], kf[1][s], e11); }
            bf16_t* Qout = QG + (size_t)it * 4096;
#pragma unroll
            for (int rho = 0; rho < 16; ++rho) { const int i0 = crow(rho, hh), i1 = 32 + i0;
                { const float gi = gcl[i0]; Qout[i0 * 64 + r] = (i0 >= r) ? (bf16_t)f2bf(e00[rho] * __expf(fminf(gi - gcj0, 0.f))) : (bf16_t)0; Qout[i0 * 64 + 32 + r] = (bf16_t)0; }
                { const float gi = gcl[i1]; Qout[i1 * 64 + r] = (bf16_t)f2bf(e10[rho] * __expf(fminf(gi - gcj0, 0.f)));
                  Qout[i1 * 64 + 32 + r] = (i1 >= 32 + r) ? (bf16_t)f2bf(e11[rho] * __expf(fminf(gi - gcj1, 0.f))) : (bf16_t)0; } }
        }
        __builtin_amdgcn_sched_barrier(0);
        {
            float Tc[64]; bf16_t* Tout = TT + (size_t)it * 4096;
#pragma unroll
            for (int i = 0; i < 64; ++i) { float p0 = (lane == i) ? 1.f : 0.f, p1 = 0.f, p2 = 0.f, p3 = 0.f;
#pragma unroll
                for (int j = 0; j < i; ++j) { const float av = Am[i * 68 + j];
                    if ((j & 3) == 0) p0 -= av * Tc[j]; else if ((j & 3) == 1) p1 -= av * Tc[j]; else if ((j & 3) == 2) p2 -= av * Tc[j]; else p3 -= av * Tc[j]; }
                Tc[i] = (p0 + p1) + (p2 + p3);
                Tout[i * 64 + lane] = (bf16_t)f2bf(Tc[i]); }
        }
        LDS_WAIT();
    }
}

constexpr int SC_K = 0, SC_Q = 64 * 136 * 2, SC_KT = SC_Q + 64 * 136 * 2, SC_T = SC_KT + 128 * 72 * 2, SC_QG = SC_T + 64 * 72 * 2, SC_V = SC_QG + 64 * 72 * 2, SC_BE = SC_V + 64 * 32 * 2, SC_EG = SC_BE + 256, SC_ED = SC_EG + 256, SC_STAGE = SC_ED + 512;
static_assert(2 * SC_STAGE <= 159744 - 16, "scan LDS");
__device__ __forceinline__ int perm16(int x) { return (x & ~12) | ((x & 4) << 1) | ((x & 8) >> 1); }

struct ScanRegs { u32x4 buf[8]; float gc, gce, be; };
struct ScanItem { const bf16_t *Kp, *Vp, *Qp, *Tp, *Gp; const float *GCp, *BEp; int t0, ts; bool isx; };
__device__ __forceinline__ ScanItem scan_item(int cidx, int dir, int b, int h, int sl, const bf16_t* KNx, const bf16_t* VNx, const bf16_t* KNc, const bf16_t* VNc, const bf16_t* QN, const float* BETA, const float* GC, const bf16_t* TT, const bf16_t* QG) {
    ScanItem I; I.isx = cidx >= 4; const int cl = I.isx ? cidx - 4 : cidx, Ls = I.isx ? SEQL : CTXL;
    I.t0 = dir ? Ls - 1 - cl * 64 : cl * 64; I.ts = dir ? -1 : 1;
    I.Kp = (I.isx ? KNx + (size_t)b * SEQL * DM : KNc + (size_t)b * CTXL * DM) + h * 128;
    I.Vp = (I.isx ? VNx + (size_t)b * SEQL * DM : VNc + (size_t)b * CTXL * DM) + h * 128 + sl * 32;
    I.Qp = QN + (size_t)b * SEQL * DM + h * 128;
    const size_t item = (size_t)((dir * 4 + b) * 8 + h) * NCH + cidx;
    I.Tp = TT + item * 4096; I.Gp = QG + item * 4096; I.GCp = GC + item * 64;
    I.BEp = BETA + ((size_t)dir * MROWS + (I.isx ? b * SEQL : NTOK + b * CTXL)) * 8 + h;
    return I;
}
__device__ __forceinline__ void scan_load(ScanRegs& R, const ScanItem& I, int tp) {
    asm volatile("" : "+v"(tp));
    if (tp < 64) { R.gc = I.GCp[tp]; R.gce = I.GCp[63]; R.be = I.BEp[(size_t)(I.t0 + I.ts * tp) * 8]; }
#pragma unroll
    for (int m = 0; m < 8; ++m) { const int p = tp + 448 * m; R.buf[m] = (u32x4){0u, 0u, 0u, 0u};
        if (p < 1024) { const int i = p & 63, p8 = p >> 6; R.buf[m] = *(const u32x4*)(I.Kp + (size_t)(I.t0 + I.ts * i) * DM + 8 * p8); }
        else if (p < 2048) { if (I.isx) { const int q = p - 1024, i = q >> 4, p8 = q & 15; R.buf[m] = *(const u32x4*)(I.Qp + (size_t)(I.t0 + I.ts * i) * DM + 8 * p8); } }
        else if (p < 2560) { const int q = p - 2048; R.buf[m] = *(const u32x4*)(I.Tp + 8 * q); }
        else if (p < 3072) { if (I.isx) { const int q = p - 2560; R.buf[m] = *(const u32x4*)(I.Gp + 8 * q); } }
        else if (p < 3328) { const int q = p - 3072, i = q >> 2, c8 = q & 3; R.buf[m] = *(const u32x4*)(I.Vp + (size_t)(I.t0 + I.ts * i) * DM + 8 * c8); } }
}
__device__ __forceinline__ void scan_write(const ScanRegs& R, bool isx, unsigned char* st, int tp) {
    asm volatile("" : "+v"(tp));
    bf16_t* kL = (bf16_t*)(st + SC_K); bf16_t* qL = (bf16_t*)(st + SC_Q); bf16_t* kTL = (bf16_t*)(st + SC_KT); bf16_t* TL = (bf16_t*)(st + SC_T); bf16_t* QL = (bf16_t*)(st + SC_QG); bf16_t* vL = (bf16_t*)(st + SC_V);
    if (tp < 64) { ((float*)(st + SC_BE))[tp] = R.be; ((float*)(st + SC_EG))[tp] = __expf(R.gc); ((float*)(st + SC_ED))[tp] = __expf(R.gce - R.gc); }
#pragma unroll
    for (int m = 0; m < 8; ++m) { const int p = tp + 448 * m; const u32x2 lo = (u32x2){R.buf[m].x, R.buf[m].y}, hi = (u32x2){R.buf[m].z, R.buf[m].w};
        const unsigned w4[4] = {R.buf[m].x, R.buf[m].y, R.buf[m].z, R.buf[m].w};
        if (p < 1024) { const int i = p & 63, p8 = p >> 6, s = p8 >> 1, a = p8 & 1;
            *(u32x2*)(kL + i * 136 + 16 * s + 4 * a) = lo; *(u32x2*)(kL + i * 136 + 16 * s + 8 + 4 * a) = hi;
            const int pi = perm16(i);
#pragma unroll
            for (int e = 0; e < 4; ++e) { kTL[(8 * p8 + 2 * e) * 72 + pi] = (bf16_t)(w4[e] & 0xffffu); kTL[(8 * p8 + 2 * e + 1) * 72 + pi] = (bf16_t)(w4[e] >> 16); } }
        else if (p < 2048) { if (isx) { const int q = p - 1024, i = q >> 4, p8 = q & 15, s = p8 >> 1, a = p8 & 1;
            *(u32x2*)(qL + i * 136 + 16 * s + 4 * a) = lo; *(u32x2*)(qL + i * 136 + 16 * s + 8 + 4 * a) = hi; } }
        else if (p < 2560) { const int q = p - 2048, i = q >> 3, p8 = q & 7, s = p8 >> 1, a = p8 & 1;
            *(u32x2*)(TL + i * 72 + 16 * s + 4 * a) = lo; *(u32x2*)(TL + i * 72 + 16 * s + 8 + 4 * a) = hi; }
        else if (p < 3072) { if (isx) { const int q = p - 2560, i = q >> 3, p8 = q & 7, s = p8 >> 1, a = p8 & 1;
            *(u32x2*)(QL + i * 72 + 16 * s + 4 * a) = lo; *(u32x2*)(QL + i * 72 + 16 * s + 8 + 4 * a) = hi; } }
        else if (p < 3328) { const int q = p - 3072, i = q >> 2, c8 = q & 3;
#pragma unroll
            for (int e = 0; e < 4; ++e) { vL[((i >> 2) * 32 + 8 * c8 + 2 * e) * 4 + (i & 3)] = (bf16_t)(w4[e] & 0xffffu); vL[((i >> 2) * 32 + 8 * c8 + 2 * e + 1) * 4 + (i & 3)] = (bf16_t)(w4[e] >> 16); } } }
}

__device__ __forceinline__ void scan_consume(const unsigned char* st, f32x16 (&S)[4], bf16x8 (&Sb)[4][2], bool isx, bf16_t* Olow, int dir, int lane) {
    int r = lane & 31, hh = lane >> 5; asm volatile("" : "+v"(r), "+v"(hh));
    const bf16_t* kL = (const bf16_t*)(st + SC_K); const bf16_t* qL = (const bf16_t*)(st + SC_Q); const bf16_t* kTL = (const bf16_t*)(st + SC_KT); const bf16_t* TL = (const bf16_t*)(st + SC_T);
    const bf16_t* QL = (const bf16_t*)(st + SC_QG); const bf16_t* vL = (const bf16_t*)(st + SC_V);
    const float* BE = (const float*)(st + SC_BE); const float* EG = (const float*)(st + SC_EG); const float* ED = (const float*)(st + SC_ED);
    bf16x8 kA[2][4];
#pragma unroll
    for (int s = 0; s < 4; ++s)
#pragma unroll
        for (int tl = 0; tl < 2; ++tl) kA[tl][s] = *(const bf16x8*)(kL + (32 * tl + r) * 136 + 16 * s + 8 * hh);
    f32x16 X[2]; X[0] = zero16(); X[1] = zero16();
#pragma unroll
    for (int s = 0; s < 8; ++s) {
#pragma unroll
        for (int tl = 0; tl < 2; ++tl) X[tl] = MFMA32(kA[tl][s & 3], Sb[s >> 1][s & 1], X[tl]);
        if (s < 4) {
#pragma unroll
            for (int tl = 0; tl < 2; ++tl) kA[tl][s & 3] = *(const bf16x8*)(kL + (32 * tl + r) * 136 + 16 * (s + 4) + 8 * hh); }
    }
    bf16x8 tA[6];
#pragma unroll
    for (int s2 = 0; s2 < 2; ++s2) { tA[3 * s2] = *(const bf16x8*)(TL + r * 72 + 16 * s2 + 8 * hh); tA[3 * s2 + 1] = *(const bf16x8*)(TL + (32 + r) * 72 + 16 * s2 + 8 * hh); tA[3 * s2 + 2] = *(const bf16x8*)(TL + (32 + r) * 72 + 32 + 16 * s2 + 8 * hh); }
    const float ee = EG[63];
#pragma unroll
    for (int tl = 0; tl < 2; ++tl)
#pragma unroll
        for (int g = 0; g < 4; ++g) { const int i0 = 32 * tl + 8 * g + 4 * hh; const f32x4 be = *(const f32x4*)(BE + i0), eg = *(const f32x4*)(EG + i0); const u32x2 vw = *(const u32x2*)(vL + ((i0 >> 2) * 32 + r) * 4);
            X[tl][4 * g + 0] = be[0] * (bflo(vw.x) - eg[0] * X[tl][4 * g + 0]); X[tl][4 * g + 1] = be[1] * (bfhi(vw.x) - eg[1] * X[tl][4 * g + 1]);
            X[tl][4 * g + 2] = be[2] * (bflo(vw.y) - eg[2] * X[tl][4 * g + 2]); X[tl][4 * g + 3] = be[3] * (bfhi(vw.y) - eg[3] * X[tl][4 * g + 3]); }
    bf16x8 Xb[2][2];
#pragma unroll
    for (int tl = 0; tl < 2; ++tl)
#pragma unroll
        for (int s2 = 0; s2 < 2; ++s2) Xb[tl][s2] = pack8(X[tl], s2);
    f32x16 Vn[2]; Vn[0] = zero16(); Vn[1] = zero16();
#pragma unroll
    for (int s2 = 0; s2 < 2; ++s2) { Vn[0] = MFMA32(tA[3 * s2], Xb[0][s2], Vn[0]); Vn[1] = MFMA32(tA[3 * s2 + 1], Xb[0][s2], Vn[1]); Vn[1] = MFMA32(tA[3 * s2 + 2], Xb[1][s2], Vn[1]); }
    bf16x8 ktA[2][4], qA[4];
#pragma unroll
    for (int tj = 0; tj < 2; ++tj)
#pragma unroll
        for (int s2 = 0; s2 < 2; ++s2) ktA[0][2 * tj + s2] = *(const bf16x8*)(kTL + r * 72 + 32 * tj + 16 * s2 + 8 * hh);
#pragma unroll
    for (int kt = 0; kt < 4; ++kt) {
#pragma unroll
        for (int rho = 0; rho < 16; ++rho) S[kt][rho] *= ee; }
    bf16x8 Vb[2][2], Vd[2][2];
#pragma unroll
    for (int tl = 0; tl < 2; ++tl) { f32x16 t;
#pragma unroll
        for (int g = 0; g < 4; ++g) { const f32x4 ed = *(const f32x4*)(ED + 32 * tl + 8 * g + 4 * hh);
#pragma unroll
            for (int e = 0; e < 4; ++e) t[4 * g + e] = Vn[tl][4 * g + e] * ed[e]; }
#pragma unroll
        for (int s2 = 0; s2 < 2; ++s2) { Vb[tl][s2] = pack8(Vn[tl], s2); Vd[tl][s2] = pack8(t, s2); } }
    f32x16 O[2]; O[0] = zero16(); O[1] = zero16();
#pragma unroll
    for (int kt = 0; kt < 4; ++kt) {
        if (isx) {
#pragma unroll
            for (int s2 = 0; s2 < 2; ++s2)
#pragma unroll
                for (int tl = 0; tl < 2; ++tl) qA[2 * s2 + tl] = *(const bf16x8*)(qL + (32 * tl + r) * 136 + 32 * kt + 16 * s2 + 8 * hh);
        }
        if (kt < 3) {
#pragma unroll
            for (int tj = 0; tj < 2; ++tj)
#pragma unroll
                for (int s2 = 0; s2 < 2; ++s2) ktA[(kt + 1) & 1][2 * tj + s2] = *(const bf16x8*)(kTL + (32 * (kt + 1) + r) * 72 + 32 * tj + 16 * s2 + 8 * hh);
        }
#pragma unroll
        for (int tj = 0; tj < 2; ++tj)
#pragma unroll
            for (int s2 = 0; s2 < 2; ++s2) S[kt] = MFMA32(ktA[kt & 1][2 * tj + s2], Vd[tj][s2], S[kt]);
        if (isx) {
#pragma unroll
            for (int s2 = 0; s2 < 2; ++s2)
#pragma unroll
                for (int tl = 0; tl < 2; ++tl) O[tl] = MFMA32(qA[2 * s2 + tl], Sb[kt][s2], O[tl]);
        }
#pragma unroll
        for (int s2 = 0; s2 < 2; ++s2) Sb[kt][s2] = pack8(S[kt], s2); }
    if (isx) {
#pragma unroll
        for (int tl = 0; tl < 2; ++tl)
#pragma unroll
            for (int g = 0; g < 4; ++g) { const f32x4 eg = *(const f32x4*)(EG + 32 * tl + 8 * g + 4 * hh);
#pragma unroll
                for (int e = 0; e < 4; ++e) O[tl][4 * g + e] *= eg[e]; }
#pragma unroll
        for (int s2 = 0; s2 < 2; ++s2) {
            O[0] = MFMA32(*(const bf16x8*)(QL + r * 72 + 16 * s2 + 8 * hh), Vb[0][s2], O[0]);
            O[1] = MFMA32(*(const bf16x8*)(QL + (32 + r) * 72 + 16 * s2 + 8 * hh), Vb[0][s2], O[1]);
            O[1] = MFMA32(*(const bf16x8*)(QL + (32 + r) * 72 + 32 + 16 * s2 + 8 * hh), Vb[1][s2], O[1]); }
        const int osgn = dir ? -1 : 1; const int lane_off = ((dir ? 63 - 4 * hh : 4 * hh) * DM + r) * 2;
#pragma unroll
        for (int tl = 0; tl < 2; ++tl)
#pragma unroll
            for (int rho = 0; rho < 16; rho += 2) { const int c0 = 32 * tl + (rho & 3) + 8 * (rho >> 2); const unsigned w = cvt2(O[tl][rho], O[tl][rho + 1]);
                *(bf16_t*)((char*)Olow + (unsigned)(lane_off + osgn * c0 * (DM * 2))) = (bf16_t)(w & 0xffffu);
                *(bf16_t*)((char*)Olow + (unsigned)(lane_off + osgn * (c0 + 1) * (DM * 2))) = (bf16_t)(w >> 16); }
    }
}

#define MFMA16(a, b, c) __builtin_amdgcn_mfma_f32_16x16x32_bf16((a), (b), (c), 0, 0, 0)
__device__ __forceinline__ int perm32(int x) { return (x & 32) | ((x & 12) << 1) | ((x & 16) >> 2) | (x & 3); }
__device__ __forceinline__ bf16x8 pack44(const f32x4& t0, const f32x4& t1) { u32x4 p; p.x = cvt2(t0[0], t0[1]); p.y = cvt2(t0[2], t0[3]); p.z = cvt2(t1[0], t1[1]); p.w = cvt2(t1[2], t1[3]); return __builtin_bit_cast(bf16x8, p); }
struct ScanRegs16 { u32x4 buf[9]; float gc, gce, be; };
__device__ __forceinline__ void scan_load16(ScanRegs16& R, const ScanItem& I, int tp) {
    asm volatile("" : "+v"(tp));
    if (tp < 64) { R.gc = I.GCp[tp]; R.gce = I.GCp[63]; R.be = I.BEp[(size_t)(I.t0 + I.ts * tp) * 8]; }
#pragma unroll
    for (int m = 0; m < 9; ++m) { const int p = tp + 384 * m; R.buf[m] = (u32x4){0u, 0u, 0u, 0u};
        if (p < 1024) { const int i = p & 63, p8 = p >> 6; R.buf[m] = *(const u32x4*)(I.Kp + (size_t)(I.t0 + I.ts * i) * DM + 8 * p8); }
        else if (p < 2048) { if (I.isx) { const int q = p - 1024, i = q >> 4, p8 = q & 15; R.buf[m] = *(const u32x4*)(I.Qp + (size_t)(I.t0 + I.ts * i) * DM + 8 * p8); } }
        else if (p < 2560) { const int q = p - 2048; R.buf[m] = *(const u32x4*)(I.Tp + 8 * q); }
        else if (p < 3072) { if (I.isx) { const int q = p - 2560; R.buf[m] = *(const u32x4*)(I.Gp + 8 * q); } }
        else if (p < 3328) { const int q = p - 3072, i = q >> 2, c8 = q & 3; R.buf[m] = *(const u32x4*)(I.Vp + (size_t)(I.t0 + I.ts * i) * DM + 8 * c8); } }
}
__device__ __forceinline__ int pos16lo(int p8) { return 32 * (p8 >> 2) + 16 * (p8 & 1) + 4 * ((p8 >> 1) & 1); }
__device__ __forceinline__ void scan_write16(const ScanRegs16& R, bool isx, unsigned char* st, int tp) {
    asm volatile("" : "+v"(tp));
    bf16_t* kL = (bf16_t*)(st + SC_K); bf16_t* qL = (bf16_t*)(st + SC_Q); bf16_t* kTL = (bf16_t*)(st + SC_KT); bf16_t* TL = (bf16_t*)(st + SC_T); bf16_t* QL = (bf16_t*)(st + SC_QG); bf16_t* vL = (bf16_t*)(st + SC_V);
    if (tp < 64) { ((float*)(st + SC_BE))[tp] = R.be; ((float*)(st + SC_EG))[tp] = __expf(R.gc); ((float*)(st + SC_ED))[tp] = __expf(R.gce - R.gc); }
#pragma unroll
    for (int m = 0; m < 9; ++m) { const int p = tp + 384 * m; const u32x2 lo = (u32x2){R.buf[m].x, R.buf[m].y}, hi = (u32x2){R.buf[m].z, R.buf[m].w};
        const unsigned w4[4] = {R.buf[m].x, R.buf[m].y, R.buf[m].z, R.buf[m].w};
        if (p < 1024) { const int i = p & 63, p8 = p >> 6, c0 = pos16lo(p8);
            *(u32x2*)(kL + i * 136 + c0) = lo; *(u32x2*)(kL + i * 136 + c0 + 8) = hi;
            const int pi = perm32(i);
#pragma unroll
            for (int e = 0; e < 4; ++e) { kTL[(8 * p8 + 2 * e) * 72 + pi] = (bf16_t)(w4[e] & 0xffffu); kTL[(8 * p8 + 2 * e + 1) * 72 + pi] = (bf16_t)(w4[e] >> 16); } }
        else if (p < 2048) { if (isx) { const int q = p - 1024, i = q >> 4, p8 = q & 15, c0 = pos16lo(p8);
            *(u32x2*)(qL + i * 136 + c0) = lo; *(u32x2*)(qL + i * 136 + c0 + 8) = hi; } }
        else if (p < 2560) { const int q = p - 2048, i = q >> 3, p8 = q & 7, c0 = pos16lo(p8);
            *(u32x2*)(TL + i * 72 + c0) = lo; *(u32x2*)(TL + i * 72 + c0 + 8) = hi; }
        else if (p < 3072) { if (isx) { const int q = p - 2560, i = q >> 3, p8 = q & 7, c0 = pos16lo(p8);
            *(u32x2*)(QL + i * 72 + c0) = lo; *(u32x2*)(QL + i * 72 + c0 + 8) = hi; } }
        else if (p < 3328) { const int q = p - 3072, i = q >> 2, c8 = q & 3;
#pragma unroll
            for (int e = 0; e < 4; ++e) { vL[((i >> 2) * 32 + 8 * c8 + 2 * e) * 4 + (i & 3)] = (bf16_t)(w4[e] & 0xffffu); vL[((i >> 2) * 32 + 8 * c8 + 2 * e + 1) * 4 + (i & 3)] = (bf16_t)(w4[e] >> 16); } } }
}
__device__ __forceinline__ void scan_consume16(const unsigned char* st, f32x4 (&S)[8], bf16x8 (&Sb)[4], bool isx, bf16_t* Olow, int dir, int cw, int lane) {
    int r = lane & 15, q = lane >> 4; asm volatile("" : "+v"(r), "+v"(q));
    const bf16_t* kL = (const bf16_t*)(st + SC_K); const bf16_t* qL = (const bf16_t*)(st + SC_Q); const bf16_t* kTL = (const bf16_t*)(st + SC_KT); const bf16_t* TL = (const bf16_t*)(st + SC_T);
    const bf16_t* QL = (const bf16_t*)(st + SC_QG); const bf16_t* vL = (const bf16_t*)(st + SC_V);
    const float* BE = (const float*)(st + SC_BE); const float* EG = (const float*)(st + SC_EG); const float* ED = (const float*)(st + SC_ED);
    const f32x4 z4f = (f32x4){0.f, 0.f, 0.f, 0.f};
    bf16x8 kA[4][4], tA[6];
#pragma unroll
    for (int kb = 0; kb < 4; ++kb)
#pragma unroll
        for (int ti = 0; ti < 4; ++ti) kA[kb][ti] = *(const bf16x8*)(kL + (16 * ti + r) * 136 + 32 * kb + 8 * q);
#pragma unroll
    for (int ti = 0; ti < 4; ++ti) tA[ti] = *(const bf16x8*)(TL + (16 * ti + r) * 72 + 8 * q);
    tA[4] = *(const bf16x8*)(TL + (32 + r) * 72 + 32 + 8 * q); tA[5] = *(const bf16x8*)(TL + (48 + r) * 72 + 32 + 8 * q);
    f32x4 beF[4], egF[4], edF[4]; u32x2 vF[4];
#pragma unroll
    for (int ti = 0; ti < 4; ++ti) { const int i0 = 16 * ti + 4 * q; beF[ti] = *(const f32x4*)(BE + i0); egF[ti] = *(const f32x4*)(EG + i0); edF[ti] = *(const f32x4*)(ED + i0); vF[ti] = *(const u32x2*)(vL + ((i0 >> 2) * 32 + 16 * cw + r) * 4); }
    const float ee = EG[63];
    LDS_WAIT();
    __builtin_amdgcn_sched_barrier(0);
    f32x4 X[4]; X[0] = z4f; X[1] = z4f; X[2] = z4f; X[3] = z4f;
#pragma unroll
    for (int kb = 0; kb < 4; ++kb)
#pragma unroll
        for (int ti = 0; ti < 4; ++ti) X[ti] = MFMA16(kA[kb][ti], Sb[kb], X[ti]);
    __builtin_amdgcn_sched_barrier(0);
    bf16x8 ktA[8][2];
#pragma unroll
    for (int t = 0; t < 8; ++t)
#pragma unroll
        for (int kb = 0; kb < 2; ++kb) ktA[t][kb] = *(const bf16x8*)(kTL + (16 * t + r) * 72 + 32 * kb + 8 * q);
    __builtin_amdgcn_sched_barrier(0);
#pragma unroll
    for (int ti = 0; ti < 4; ++ti) { const f32x4 be = beF[ti], eg = egF[ti]; const u32x2 vw = vF[ti];
        X[ti][0] = be[0] * (bflo(vw.x) - eg[0] * X[ti][0]); X[ti][1] = be[1] * (bfhi(vw.x) - eg[1] * X[ti][1]); X[ti][2] = be[2] * (bflo(vw.y) - eg[2] * X[ti][2]); X[ti][3] = be[3] * (bfhi(vw.y) - eg[3] * X[ti][3]); }
    bf16x8 Xb[2]; Xb[0] = pack44(X[0], X[1]); Xb[1] = pack44(X[2], X[3]);
    f32x4 Vn[4];
#pragma unroll
    for (int ti = 0; ti < 4; ++ti) Vn[ti] = MFMA16(tA[ti], Xb[0], z4f);
    Vn[2] = MFMA16(tA[4], Xb[1], Vn[2]); Vn[3] = MFMA16(tA[5], Xb[1], Vn[3]);
    f32x4 Vs[4];
#pragma unroll
    for (int ti = 0; ti < 4; ++ti) Vs[ti] = Vn[ti] * edF[ti];
    bf16x8 Vb[2], Vd[2]; Vb[0] = pack44(Vn[0], Vn[1]); Vb[1] = pack44(Vn[2], Vn[3]); Vd[0] = pack44(Vs[0], Vs[1]); Vd[1] = pack44(Vs[2], Vs[3]);
    LDS_WAIT();
    __builtin_amdgcn_sched_barrier(0);
#pragma unroll
    for (int t = 0; t < 8; ++t) { S[t] = S[t] * ee;
#pragma unroll
        for (int kb = 0; kb < 2; ++kb) S[t] = MFMA16(ktA[t][kb], Vd[kb], S[t]); }
    __builtin_amdgcn_sched_barrier(0);
    f32x4 O[4]; O[0] = z4f; O[1] = z4f; O[2] = z4f; O[3] = z4f;
    if (isx) {
        bf16x8 qA[4][4], gA[6];
#pragma unroll
        for (int kb = 0; kb < 4; ++kb)
#pragma unroll
            for (int ti = 0; ti < 4; ++ti) qA[kb][ti] = *(const bf16x8*)(qL + (16 * ti + r) * 136 + 32 * kb + 8 * q);
#pragma unroll
        for (int ti = 0; ti < 4; ++ti) gA[ti] = *(const bf16x8*)(QL + (16 * ti + r) * 72 + 8 * q);
        gA[4] = *(const bf16x8*)(QL + (32 + r) * 72 + 32 + 8 * q); gA[5] = *(const bf16x8*)(QL + (48 + r) * 72 + 32 + 8 * q);
        LDS_WAIT();
        __builtin_amdgcn_sched_barrier(0);
#pragma unroll
        for (int kb = 0; kb < 4; ++kb)
#pragma unroll
            for (int ti = 0; ti < 4; ++ti) O[ti] = MFMA16(qA[kb][ti], Sb[kb], O[ti]);
#pragma unroll
        for (int ti = 0; ti < 4; ++ti) { O[ti] = O[ti] * egF[ti]; O[ti] = MFMA16(gA[ti], Vb[0], O[ti]); }
        O[2] = MFMA16(gA[4], Vb[1], O[2]); O[3] = MFMA16(gA[5], Vb[1], O[3]);
    }
#pragma unroll
    for (int kb = 0; kb < 4; ++kb) Sb[kb] = pack44(S[2 * kb], S[2 * kb + 1]);
    if (isx) {
        const int osgn = dir ? -1 : 1; const int lane_off = ((dir ? 63 - 4 * q : 4 * q) * DM + 16 * cw + r) * 2;
#pragma unroll
        for (int ti = 0; ti < 4; ++ti)
#pragma unroll
            for (int e = 0; e < 4; e += 2) { const int c0 = 16 * ti + e; const unsigned w = cvt2(O[ti][e], O[ti][e + 1]);
                *(bf16_t*)((char*)Olow + (unsigned)(lane_off + osgn * c0 * (DM * 2))) = (bf16_t)(w & 0xffffu);
                *(bf16_t*)((char*)Olow + (unsigned)(lane_off + osgn * (c0 + 1) * (DM * 2))) = (bf16_t)(w >> 16); }
    }
}

struct ChunkPtrs { const char *Kl, *Ql, *Vl, *Tp, *Gp; const float *GCp, *BEl; bool isx; };
__device__ __forceinline__ ChunkPtrs chunk_ptrs(int cidx, int dir, int b, int h, int sl, const bf16_t* KNx, const bf16_t* VNx, const bf16_t* KNc, const bf16_t* VNc, const bf16_t* QN, const float* BETA, const float* GC, const bf16_t* TT, const bf16_t* QG) {
    ChunkPtrs C; C.isx = cidx >= 4; const int cl = C.isx ? cidx - 4 : cidx, Ls = C.isx ? SEQL : CTXL;
    const int tlow = dir ? Ls - 64 - cl * 64 : cl * 64;
    C.Kl = (const char*)((C.isx ? KNx + (size_t)b * SEQL * DM : KNc + (size_t)b * CTXL * DM) + (size_t)tlow * DM + h * 128);
    C.Vl = (const char*)((C.isx ? VNx + (size_t)b * SEQL * DM : VNc + (size_t)b * CTXL * DM) + (size_t)tlow * DM + h * 128 + sl * 32);
    C.Ql = (const char*)(QN + ((size_t)b * SEQL + tlow) * DM + h * 128);
    const size_t item = (size_t)((dir * 4 + b) * 8 + h) * NCH + cidx;
    C.Tp = (const char*)(TT + item * 4096); C.Gp = (const char*)(QG + item * 4096); C.GCp = GC + item * 64;
    C.BEl = BETA + ((size_t)dir * MROWS + (C.isx ? b * SEQL : NTOK + b * CTXL) + tlow) * 8 + h;
    return C;
}
template <int NPW> struct PRegs { u32x4 buf[(52 + NPW - 1) / NPW]; float gc, gce, be; };
template <int NPW, int PW> __device__ __forceinline__ void prod_load(PRegs<NPW>& R, const ChunkPtrs& C, int dir, int lane) {
    constexpr int NS = (52 + NPW - 1) / NPW;
    asm volatile("" : "+v"(lane));
    if (PW == NPW - 1) { if (lane < 64) { R.gc = C.GCp[lane]; R.gce = C.GCp[63]; R.be = C.BEl[(dir ? 63 - lane : lane) * 8]; } }
#pragma unroll
    for (int m = 0; m < NS; ++m) { const int j = PW + NPW * m; R.buf[m] = (u32x4){0u, 0u, 0u, 0u};
        if (j < 16) { const int tr = dir ? 63 - lane : lane; R.buf[m] = *(const u32x4*)(C.Kl + (unsigned)(tr * (DM * 2) + 16 * j)); }
        else if (j < 32) { if (C.isx) { const int i = 4 * (j - 16) + (lane >> 4), tr = dir ? 63 - i : i; R.buf[m] = *(const u32x4*)(C.Ql + (unsigned)(tr * (DM * 2) + 16 * (lane & 15))); } }
        else if (j < 40) { if ((lane & 7) <= j - 32) R.buf[m] = *(const u32x4*)(C.Tp + (unsigned)((64 * (j - 32) + lane) * 16)); }
        else if (j < 48) { if (C.isx && (lane & 7) <= j - 40) R.buf[m] = *(const u32x4*)(C.Gp + (unsigned)((64 * (j - 40) + lane) * 16)); }
        else if (j < 52) { const int i = 16 * (j - 48) + (lane >> 2), tr = dir ? 63 - i : i; R.buf[m] = *(const u32x4*)(C.Vl + (unsigned)(tr * (DM * 2) + 16 * (lane & 3))); } }
}
template <int P16> __device__ __forceinline__ int colpos(int p8) { return P16 ? pos16lo(p8) : (16 * (p8 >> 1) + 4 * (p8 & 1)); }
template <int NPW, int PW, int P16> __device__ __forceinline__ void prod_write(const PRegs<NPW>& R, bool isx, unsigned char* st, int lane) {
    constexpr int NS = (52 + NPW - 1) / NPW;
    asm volatile("" : "+v"(lane));
    if (PW == NPW - 1) { if (lane < 64) { ((float*)(st + SC_BE))[lane] = R.be; ((float*)(st + SC_EG))[lane] = __expf(R.gc); ((float*)(st + SC_ED))[lane] = __expf(R.gce - R.gc); } }
#pragma unroll
    for (int m = 0; m < NS; ++m) { const int j = PW + NPW * m; const u32x2 lo = (u32x2){R.buf[m].x, R.buf[m].y}, hi = (u32x2){R.buf[m].z, R.buf[m].w};
        const unsigned w4[4] = {R.buf[m].x, R.buf[m].y, R.buf[m].z, R.buf[m].w};
        if (j < 16) { unsigned char* d = st + SC_K + lane * 272 + colpos<P16>(j) * 2; *(u32x2*)d = lo; *(u32x2*)(d + 16) = hi;
            unsigned char* t = st + SC_KT + (8 * j) * 144 + (P16 ? perm32(lane) : perm16(lane)) * 2;
#pragma unroll
            for (int e = 0; e < 4; ++e) { *(bf16_t*)(t + (2 * e) * 144) = (bf16_t)(w4[e] & 0xffffu); *(bf16_t*)(t + (2 * e + 1) * 144) = (bf16_t)(w4[e] >> 16); } }
        else if (j < 32) { if (isx) { unsigned char* d = st + SC_Q + (4 * (j - 16) + (lane >> 4)) * 272 + colpos<P16>(lane & 15) * 2; *(u32x2*)d = lo; *(u32x2*)(d + 16) = hi; } }
        else if (j < 40) { unsigned char* d = st + SC_T + (8 * (j - 32) + (lane >> 3)) * 144 + colpos<P16>(lane & 7) * 2; *(u32x2*)d = lo; *(u32x2*)(d + 16) = hi; }
        else if (j < 48) { if (isx) { unsigned char* d = st + SC_QG + (8 * (j - 40) + (lane >> 3)) * 144 + colpos<P16>(lane & 7) * 2; *(u32x2*)d = lo; *(u32x2*)(d + 16) = hi; } }
        else if (j < 52) { const int i = 16 * (j - 48) + (lane >> 2); unsigned char* d = st + SC_V + (((i >> 2) * 32 + 8 * (lane & 3)) * 4 + (i & 3)) * 2;
#pragma unroll
            for (int e = 0; e < 4; ++e) { *(bf16_t*)(d + 16 * e) = (bf16_t)(w4[e] & 0xffffu); *(bf16_t*)(d + 16 * e + 8) = (bf16_t)(w4[e] >> 16); } } }
}
template <int NPW, int PW, int P16> __device__ __forceinline__ void prod_run(unsigned char* shm, int dir, int b, int h, int sl, const bf16_t* KNx, const bf16_t* VNx, const bf16_t* KNc, const bf16_t* VNc, const bf16_t* QN,
                                                                             const float* BETA, const float* GC, const bf16_t* TT, const bf16_t* QG, int lane) {
#define CPT(c) chunk_ptrs((c), dir, b, h, sl, KNx, VNx, KNc, VNc, QN, BETA, GC, TT, QG)
    PRegs<NPW> RA, RB;
    prod_load<NPW, PW>(RA, CPT(0), dir, lane);
    prod_write<NPW, PW, P16>(RA, false, shm, lane);
    prod_load<NPW, PW>(RB, CPT(1), dir, lane);
    prod_load<NPW, PW>(RA, CPT(2), dir, lane);
    __syncthreads();
    for (int n = 0; n < NCH; n += 2) {
        prod_write<NPW, PW, P16>(RB, n + 1 >= 4, shm + SC_STAGE, lane);
        if (n + 3 < NCH) prod_load<NPW, PW>(RB, CPT(n + 3), dir, lane);
        __syncthreads();
        if (n + 2 < NCH) prod_write<NPW, PW, P16>(RA, n + 2 >= 4, shm, lane);
        if (n + 4 < NCH) prod_load<NPW, PW>(RA, CPT(n + 4), dir, lane);
        __syncthreads();
    }
#undef CPT
}

__device__ __forceinline__ void phase_scan_chunked(unsigned char* shm, const bf16_t* KNx, const bf16_t* VNx, const bf16_t* KNc, const bf16_t* VNc, const bf16_t* QN, const float* BETA, const float* GC,
                                                   const bf16_t* TT, const bf16_t* QG, bf16_t* OF, bf16_t* OB, int wave, int lane, int tid) {
    for (int it = blockIdx.x; it < 256; it += gridDim.x) {
        const int scan = (it >> 5) * 8 + (it & 7), sl = (it >> 3) & 3;
        const int dir = scan >> 5, b = (scan >> 3) & 3, h = scan & 7;
        bf16_t* Obase = (dir ? OB : OF) + (size_t)b * SEQL * DM + h * 128 + sl * 32;
        __syncthreads();
#if SCAN16
        if (wave < 2) {
            f32x4 S[8]; bf16x8 Sb[4];
#pragma unroll
            for (int t = 0; t < 8; ++t) S[t] = (f32x4){0.f, 0.f, 0.f, 0.f};
#pragma unroll
            for (int kb = 0; kb < 4; ++kb) Sb[kb] = (bf16x8){0, 0, 0, 0, 0, 0, 0, 0};
            __syncthreads();
            for (int n = 0; n < NCH; ++n) {
                const bool isx = n >= 4; const int cl = isx ? n - 4 : n;
                const int tlow = dir ? SEQL - 64 - cl * 64 : cl * 64;
                scan_consume16(shm + (n & 1) * SC_STAGE, S, Sb, isx, Obase + (size_t)tlow * DM, dir, wave, lane);
                asm volatile("" ::: "memory"); __builtin_amdgcn_s_barrier(); asm volatile("" ::: "memory");
            }
        } else {
#define PRUN(PW) prod_run<6, PW, 1>(shm, dir, b, h, sl, KNx, VNx, KNc, VNc, QN, BETA, GC, TT, QG, lane)
            switch (wave) { case 2: PRUN(0); break; case 3: PRUN(1); break; case 4: PRUN(2); break; case 5: PRUN(3); break; case 6: PRUN(4); break; default: PRUN(5); break; }
#undef PRUN
        }
#else
        if (wave == 0) {
            f32x16 S[4]; bf16x8 Sb[4][2];
#pragma unroll
            for (int kt = 0; kt < 4; ++kt) { S[kt] = zero16(); Sb[kt][0] = (bf16x8){0, 0, 0, 0, 0, 0, 0, 0}; Sb[kt][1] = (bf16x8){0, 0, 0, 0, 0, 0, 0, 0}; }
            __syncthreads();
            for (int n = 0; n < NCH; ++n) {
                const bool isx = n >= 4; const int cl = isx ? n - 4 : n;
                const int tlow = dir ? SEQL - 64 - cl * 64 : cl * 64;
                scan_consume(shm + (n & 1) * SC_STAGE, S, Sb, isx, Obase + (size_t)tlow * DM, dir, lane);
                __syncthreads();
            }
        } else {
#define PRUN(PW) prod_run<7, PW, 0>(shm, dir, b, h, sl, KNx, VNx, KNc, VNc, QN, BETA, GC, TT, QG, lane)
            switch (wave) { case 1: PRUN(0); break; case 2: PRUN(1); break; case 3: PRUN(2); break; case 4: PRUN(3); break; case 5: PRUN(4); break; case 6: PRUN(5); break; default: PRUN(6); break; }
#undef PRUN
        }
#endif
    }
}

__device__ __forceinline__ void phase_ogate(const Args& a, bf16_t* OF, const bf16_t* OB, const bf16_t* ZS, int gw, int NGW, int lane) {
    const float* og = a.in[11];
    for (int r0 = gw; r0 < NTOK; r0 += 2 * NGW) {
        const int r1 = r0 + NGW; const bool has1 = r1 < NTOK; const int rr[2] = {r0, has1 ? r1 : r0};
        u32x4 L[2][6];
#pragma unroll
        for (int u = 0; u < 2; ++u) { const size_t off = (size_t)rr[u] * DM + lane * 16;
            L[u][0] = *(const u32x4*)(OF + off); L[u][1] = *(const u32x4*)(OF + off + 8); L[u][2] = *(const u32x4*)(OB + off); L[u][3] = *(const u32x4*)(OB + off + 8); L[u][4] = *(const u32x4*)(ZS + off); L[u][5] = *(const u32x4*)(ZS + off + 8); }
#pragma unroll
        for (int u = 0; u < 2; ++u) { if (u == 1 && !has1) break;
            const size_t off = (size_t)rr[u] * DM + lane * 16;
            const unsigned fu[8] = {L[u][0].x, L[u][0].y, L[u][0].z, L[u][0].w, L[u][1].x, L[u][1].y, L[u][1].z, L[u][1].w}, bu[8] = {L[u][2].x, L[u][2].y, L[u][2].z, L[u][2].w, L[u][3].x, L[u][3].y, L[u][3].z, L[u][3].w},
                           zu[8] = {L[u][4].x, L[u][4].y, L[u][4].z, L[u][4].w, L[u][5].x, L[u][5].y, L[u][5].z, L[u][5].w};
            float o[16]; float ss = 0.f;
#pragma unroll
            for (int e = 0; e < 8; ++e) { o[2 * e] = bflo(fu[e]) + bflo(bu[e]); o[2 * e + 1] = bfhi(fu[e]) + bfhi(bu[e]); ss += o[2 * e] * o[2 * e] + o[2 * e + 1] * o[2 * e + 1]; }
            ss += __shfl_xor(ss, 1); ss += __shfl_xor(ss, 2); ss += __shfl_xor(ss, 4);
            const float rs = 1.0f / sqrtf(ss * (1.0f / HD) + EPS);
            const float* gp = og + (lane & 7) * 16;
            unsigned w[8];
#pragma unroll
            for (int e = 0; e < 8; ++e) w[e] = pk2(o[2 * e] * rs * gp[2 * e] * bflo(zu[e]), o[2 * e + 1] * rs * gp[2 * e + 1] * bfhi(zu[e]));
            *(u32x4*)(OF + off) = (u32x4){w[0], w[1], w[2], w[3]}; *(u32x4*)(OF + off + 8) = (u32x4){w[4], w[5], w[6], w[7]}; }
    }
}

__device__ __forceinline__ void phase_final(float* X, const float* g, int gw, int NGW, int lane) {
    for (int r = gw; r < NTOK; r += NGW) {
        float* src = X + (size_t)r * DM;
        f32x4 v[4]; float ss = 0.f;
#pragma unroll
        for (int j = 0; j < 4; ++j) { v[j] = *(const f32x4*)(src + 4 * lane + 256 * j); ss += (v[j][0] * v[j][0] + v[j][1] * v[j][1]) + (v[j][2] * v[j][2] + v[j][3] * v[j][3]); }
        ss = wave_sum(ss);
        const float rs = 1.0f / sqrtf(ss * (1.0f / DM) + EPS);
#pragma unroll
        for (int j = 0; j < 4; ++j) { const f32x4 gg = *(const f32x4*)(g + 4 * lane + 256 * j); *(f32x4*)(src + 4 * lane + 256 * j) = v[j] * rs * gg; }
    }
}

#define LAS __attribute__((address_space(3)))
#define XB_TMO      128
#define XB_XCNT(j)  (256  + 64 * (j))
#define XB_XSUB(j)  (1280 + 64 * (j))
#define XB_XGEN(j)  (2304 + 64 * (j))
#define XB_TOP      3328
#define XB_TOPGEN   3392
#define XCD_BAR_WORDS 3456
#define XB_SPIN_CAP (1u << 18)

__device__ __forceinline__ unsigned xb_ld(unsigned* p)              { return __hip_atomic_load(p, __ATOMIC_RELAXED, __HIP_MEMORY_SCOPE_AGENT); }
__device__ __forceinline__ unsigned xb_add(unsigned* p, unsigned v) { return __hip_atomic_fetch_add(p, v, __ATOMIC_RELAXED, __HIP_MEMORY_SCOPE_AGENT); }
__device__ __forceinline__ unsigned xb_xcc_id() { return (unsigned)__builtin_amdgcn_s_getreg((3 << 11) | 20) & 0xFu; }
#define XB_SPIN(cond, bar) do { unsigned _sp = 0; while (cond) { __builtin_amdgcn_s_sleep(1); \
    if ((++_sp & 255u) == 0u) { if (xb_ld(&(bar)[XB_TMO])) break; if (_sp > XB_SPIN_CAP) { atomicAdd(&(bar)[XB_TMO], 1u); break; } } } } while (0)

struct XcdBarrier {
    unsigned* bar; unsigned x;
    volatile LAS unsigned* st;
};

__device__ __forceinline__ XcdBarrier xcd_barrier_post(unsigned* bar, volatile LAS unsigned* st) {
    XcdBarrier b; b.bar = bar; b.x = xb_xcc_id(); b.st = st;
    if (threadIdx.x == 0) (void)xb_add(&bar[XB_XCNT(b.x)], 1u);
    return b;
}
__device__ __forceinline__ void xcd_barrier_complete(unsigned* bar, unsigned x, unsigned& nloc, unsigned& nx) {
    const unsigned G = gridDim.x * gridDim.y * gridDim.z;
    unsigned sum, cnt, mine, sp = 0u;
    for (;;) {
        sum = 0u; cnt = 0u; mine = 0u;
#pragma unroll
        for (unsigned j = 0; j < 16; ++j) { const unsigned c = xb_ld(&bar[XB_XCNT(j)]); sum += c; cnt += (c > 0u) ? 1u : 0u; mine = (j == x) ? c : mine; }
        if (sum == G) break;
        __builtin_amdgcn_s_sleep(1);
        if ((++sp & 255u) == 0u) { if (xb_ld(&bar[XB_TMO])) break; if (sp > XB_SPIN_CAP) { atomicAdd(&bar[XB_TMO], 1u); break; } }
    }
    nloc = mine > 0u ? mine : 1u; nx = cnt > 0u ? cnt : 1u;
}

__device__ __forceinline__ void xcd_barrier(const XcdBarrier& b) {
    asm volatile("s_waitcnt vmcnt(0)" ::: "memory");
    __syncthreads();
    if (threadIdx.x == 0) {
        unsigned* bar = b.bar;
        __builtin_amdgcn_s_waitcnt(0);
        unsigned nloc = b.st[0], nx = b.st[1];
        if (nloc == 0u) { xcd_barrier_complete(bar, b.x, nloc, nx); b.st[0] = nloc; b.st[1] = nx; }
        const unsigned old = xb_add(&bar[XB_XSUB(b.x)], 1u);
        const unsigned gen = old / nloc;
        if (old + 1u == (gen + 1u) * nloc) {
            __builtin_amdgcn_fence(__ATOMIC_RELEASE, "agent");
            asm volatile("s_waitcnt vmcnt(0)" ::: "memory");
            const unsigned og = xb_add(&bar[XB_TOP], 1u);
            const unsigned tg = og / nx;
            if (og + 1u == (tg + 1u) * nx) xb_add(&bar[XB_TOPGEN], 1u);
            else XB_SPIN(xb_ld(&bar[XB_TOPGEN]) == tg, bar);
            __builtin_amdgcn_fence(__ATOMIC_ACQUIRE, "agent");
            xb_add(&bar[XB_XGEN(b.x)], 1u);
            asm volatile("s_waitcnt vmcnt(0)" ::: "memory");
        } else {
            XB_SPIN(xb_ld(&bar[XB_XGEN(b.x)]) == gen, bar);
            __builtin_amdgcn_fence(__ATOMIC_ACQUIRE, "agent");
            asm volatile("s_waitcnt vmcnt(0)" ::: "memory");
        }
    }
    __syncthreads();
}


__global__ void __launch_bounds__(512, 2) mk_fwd(Args a) {
    extern __shared__ __attribute__((aligned(16))) unsigned char shm[];
    const int tid = threadIdx.x, lane = tid & 63, wave = __builtin_amdgcn_readfirstlane(tid >> 6);
    const int G = gridDim.x, gw = blockIdx.x * 8 + wave, NGW = G * 8;
    unsigned char* ws = a.ws;
    PG8_LAS unsigned char* lds = (PG8_LAS unsigned char*)shm;
    const int lo = a.ph_lo, hi = a.ph_hi;
    float* MOD = (float*)(ws + WS_MOD);
    bf16_t* UG = (bf16_t*)a.out; bf16_t* VG = UG + (size_t)NTOK * DM;
    bf16_t* KNx = (bf16_t*)a.out; bf16_t* VNx = KNx + (size_t)NTOK * DM;
#define IN(k) (lo <= (k) && (k) < hi)
#ifndef REP_K
#define REP_K -1
#endif
#define REPS(k) for (int rp_ = 0; rp_ < ((k) == REP_K ? 2 : 1); ++rp_)
    volatile LAS unsigned* bst = (volatile LAS unsigned*)(lds + (LDS_BYTES - 16));
    if (tid < 4) bst[tid] = 0u;
    __syncthreads();
    XcdBarrier xbar; xbar.bar = (unsigned*)(ws + WS_CTL); xbar.x = 0; xbar.st = bst;
    if (a.coop) xbar = xcd_barrier_post((unsigned*)(ws + WS_CTL), bst);
#define SEAM(k) do { if (IN(k) && IN((k) + 1)) { if (a.coop == 2) cg::this_grid().sync(); else if (a.coop) xcd_barrier(xbar); } } while (0)

    const bool fuse_norm = (a.coop != 0) && (G == 256);
    bf16_t* OFp = (bf16_t*)(ws + WS_OF); bf16_t* OBp = (bf16_t*)(ws + WS_OB);
    if (IN(0)) REPS(0) { phase0(a, shm, gw, NGW, wave, lane, tid); } SEAM(0);
    if (IN(1)) REPS(1) { norm_mod_rows(a.in[0], NTOK, a.in[2], NCTX, a.in[6], MOD, 0, 1024, (bf16_t*)(ws + WS_A1), gw, NGW, lane); } SEAM(1);
#ifdef DUP_GEMM2
    if (IN(2)) {
        pg8::Gemm g{(const bf16_t*)(ws + WS_A1), (const bf16_t*)(ws + WS_W1T), MROWS, 3328, DM};
        Order1a S{G, (int)blockIdx.x};
        EpiSel E{(bf16_t*)(ws + WS_R1), (bf16_t*)(ws + WS_R1) + 1024, (bf16_t*)(ws + WS_QRAW), nullptr, nullptr, 2048, 2048, 1024, 0, 0, 0, 0, 0, 0, 0, 12, (float*)(ws + WS_BA)};
        pg8::gemm_phase<EpiSel, Order1a, false>(lds, g, S, E, nullptr);
    }
#endif
    if (IN(2)) {
        pg8::Gemm g{(const bf16_t*)(ws + WS_A1), (const bf16_t*)(ws + WS_W1T), MROWS, 3328, DM};
        Order1a S{G, (int)blockIdx.x};
        EpiSel E{(bf16_t*)(ws + WS_R1), (bf16_t*)(ws + WS_R1) + 1024, (bf16_t*)(ws + WS_QRAW), nullptr, nullptr, 2048, 2048, 1024, 0, 0, 0, 0, 0, 0, 0, 12, (float*)(ws + WS_BA)};
        pg8::gemm_phase<EpiSel, Order1a, false>(lds, g, S, E, nullptr);
    } SEAM(2);
    if (IN(3)) REPS(3) { phase_conv_prep(a, (const bf16_t*)(ws + WS_R1), (const bf16_t*)(ws + WS_QRAW), (const float*)(ws + WS_BA), KNx, VNx, (bf16_t*)(ws + WS_KNC), (bf16_t*)(ws + WS_VNC), (bf16_t*)(ws + WS_QN),
                                 (float*)(ws + WS_BETA), (float*)(ws + WS_G), gw, NGW, lane); } SEAM(3);
    if (IN(4)) REPS(4) {
#if USE_CHUNKED
        phase_chunk_prep(shm, KNx, (const bf16_t*)(ws + WS_KNC), (const bf16_t*)(ws + WS_QN), (const float*)(ws + WS_BETA), (const float*)(ws + WS_G),
                         (bf16_t*)(ws + WS_TT), (bf16_t*)(ws + WS_QG), (float*)(ws + WS_GC), gw, NGW, wave, lane);
#endif
    } SEAM(4);
    if (IN(5)) REPS(5) {
#if USE_CHUNKED
        phase_scan_chunked(shm, KNx, VNx, (const bf16_t*)(ws + WS_KNC), (const bf16_t*)(ws + WS_VNC), (const bf16_t*)(ws + WS_QN), (const float*)(ws + WS_BETA), (const float*)(ws + WS_GC),
                           (const bf16_t*)(ws + WS_TT), (const bf16_t*)(ws + WS_QG), OFp, OBp, wave, lane, tid);
#else
        phase_scan(KNx, VNx, (const bf16_t*)(ws + WS_KNC), (const bf16_t*)(ws + WS_VNC), (const bf16_t*)(ws + WS_QN), (const float*)(ws + WS_BETA), (const float*)(ws + WS_G), OFp, OBp, gw, NGW, lane);
#endif
    } SEAM(5);
#ifdef DUP_GEMM6
    if (IN(6)) {
        pg8::Gemm g{(const bf16_t*)(ws + WS_A1), (const bf16_t*)(ws + WS_W1T) + (size_t)3328 * DM, NTOK, 5120, DM};
        pg8::StaticOrder S; S.init(NTOK, 5120, G, (int)blockIdx.x);
        EpiSel E{UG, VG, (bf16_t*)(ws + WS_ZS), (bf16_t*)(ws + WS_GA), (bf16_t*)(ws + WS_GB), 1024, 1024, 1024, 1024, 1024, 1, 1, 2, 3, 3, -1, nullptr};
        pg8::gemm_phase<EpiSel, pg8::StaticOrder, false>(lds, g, S, E, nullptr);
    }
#endif
    if (IN(6)) {
        pg8::Gemm g{(const bf16_t*)(ws + WS_A1), (const bf16_t*)(ws + WS_W1T) + (size_t)3328 * DM, NTOK, 5120, DM};
        pg8::StaticOrder S; S.init(NTOK, 5120, G, (int)blockIdx.x);
        EpiSel E{UG, VG, (bf16_t*)(ws + WS_ZS), (bf16_t*)(ws + WS_GA), (bf16_t*)(ws + WS_GB), 1024, 1024, 1024, 1024, 1024, 1, 1, 2, 3, 3, -1, nullptr};
        pg8::gemm_phase<EpiSel, pg8::StaticOrder, false>(lds, g, S, E, nullptr);
    } SEAM(6);
    if (IN(7) && IN(8)) {
        phase_branch_a(a, shm, UG, VG, (bf16_t*)(ws + WS_AA), wave, lane, tid);
        phase_ogate(a, OFp, OBp, (const bf16_t*)(ws + WS_ZS), gw, NGW, lane);
    } else {
        if (IN(7)) phase_ogate(a, OFp, OBp, (const bf16_t*)(ws + WS_ZS), gw, NGW, lane);
        if (IN(8)) phase_branch_a(a, shm, UG, VG, (bf16_t*)(ws + WS_AA), wave, lane, tid);
    } SEAM(8);
#ifdef DUP_GEMM9
    if (IN(9)) {
        pg8::Gemm g{(const bf16_t*)(ws + WS_AA), (const bf16_t*)(ws + WS_WAT), NTOK, DM, DM};
        pg8::StaticOrder S; S.init(NTOK, DM, G, (int)blockIdx.x);
        EpiGate E{(const bf16_t*)(ws + WS_GA), nullptr, (bf16_t*)(ws + WS_T1)};
        pg8::gemm_phase<EpiGate, pg8::StaticOrder, false>(lds, g, S, E, nullptr);
    }
#endif
    static_assert(WS_OF - WS_AA == (size_t)204 * 256 * DM * 2 && WS_WBT - WS_WAT == (size_t)4 * 256 * DM * 2, "OrderAB aliasing");
    if (IN(9) && IN(10)) {
        pg8::Gemm g{(const bf16_t*)(ws + WS_AA), (const bf16_t*)(ws + WS_WAT), NTOK, DM, DM};
        OrderAB S; S.S0.init(NTOK, DM, G, (int)blockIdx.x);
        EpiGateAB E{(const bf16_t*)(ws + WS_GA), (const bf16_t*)(ws + WS_GB), (bf16_t*)(ws + WS_MG)};
        pg8::gemm_phase<EpiGateAB, OrderAB, false>(lds, g, S, E, nullptr);
    } else {
    if (IN(9)) {
        pg8::Gemm g{(const bf16_t*)(ws + WS_AA), (const bf16_t*)(ws + WS_WAT), NTOK, DM, DM};
        pg8::StaticOrder S; S.init(NTOK, DM, G, (int)blockIdx.x);
        EpiGate E{(const bf16_t*)(ws + WS_GA), nullptr, (bf16_t*)(ws + WS_T1)};
        pg8::gemm_phase<EpiGate, pg8::StaticOrder, false>(lds, g, S, E, nullptr);
    }
    if (IN(10)) {
        pg8::Gemm g{(const bf16_t*)(ws + WS_OF), (const bf16_t*)(ws + WS_WBT), NTOK, DM, DM};
        pg8::StaticOrder S; S.init(NTOK, DM, G, (int)blockIdx.x);
        EpiGate E{(const bf16_t*)(ws + WS_GB), (const bf16_t*)(ws + WS_T1), (bf16_t*)(ws + WS_MG)};
        pg8::gemm_phase<EpiGate, pg8::StaticOrder, false>(lds, g, S, E, nullptr);
    }
    } SEAM(10);
    if (IN(11)) {
        pg8::Gemm g{(const bf16_t*)(ws + WS_MG), (const bf16_t*)(ws + WS_WOT), NTOK, DM, DM};
        pg8::StaticOrder S; S.init(NTOK, DM, G, (int)blockIdx.x);
        if (fuse_norm) {
            EpiResNorm<1> E{a.in[0], a.out, MOD + 2048, a.in[19], MOD, 3072, 4096, (bf16_t*)(ws + WS_A1), (float*)(ws + WS_XB), (unsigned*)(ws + WS_CTL + 16384)};
            pg8::gemm_phase<EpiResNorm<1>, pg8::StaticOrder, false>(lds, g, S, E, nullptr);
        } else {
            EpiRes E{a.in[0], a.out, MOD + 2048};
            pg8::gemm_phase<EpiRes, pg8::StaticOrder, false>(lds, g, S, E, nullptr);
        }
    } SEAM(11);
    if (IN(12) && !fuse_norm) { norm_mod_rows(a.out, NTOK, nullptr, 0, a.in[19], MOD, 3072, 4096, (bf16_t*)(ws + WS_A1), gw, NGW, lane); }
    if (!fuse_norm) SEAM(12);
#ifdef DUP_GEMM13
    if (IN(13)) {
        pg8::Gemm g{(const bf16_t*)(ws + WS_A1), (const bf16_t*)(ws + WS_WUPT), NTOK, 2 * DFF, DM};
        pg8::StaticOrder S; S.init(NTOK, 2 * DFF, G, (int)blockIdx.x);
        EpiUp E{a.in[21], a.in[22], (bf16_t*)(ws + WS_R1)};
        pg8::gemm_phase<EpiUp, pg8::StaticOrder, false>(lds, g, S, E, nullptr);
    }
#endif
    if (IN(13)) {
        pg8::Gemm g{(const bf16_t*)(ws + WS_A1), (const bf16_t*)(ws + WS_WUPT), NTOK, 2 * DFF, DM};
        pg8::StaticOrder S; S.init(NTOK, 2 * DFF, G, (int)blockIdx.x);
        EpiUp E{a.in[21], a.in[22], (bf16_t*)(ws + WS_R1)};
        pg8::gemm_phase<EpiUp, pg8::StaticOrder, false>(lds, g, S, E, nullptr);
    } SEAM(13);
    if (IN(14)) {
        pg8::Gemm g{(const bf16_t*)(ws + WS_R1), (const bf16_t*)(ws + WS_WDT), NTOK, DM, DFF};
        pg8::StaticOrder S; S.init(NTOK, DM, G, (int)blockIdx.x);
        if (fuse_norm) {
            EpiResNorm<0> E{a.out, a.out, MOD + 5120, a.in[24], nullptr, 0, 0, nullptr, (float*)(ws + WS_XB), (unsigned*)(ws + WS_CTL + 32768)};
            pg8::gemm_phase<EpiResNorm<0>, pg8::StaticOrder, false>(lds, g, S, E, nullptr);
        } else {
            EpiRes E{a.out, a.out, MOD + 5120};
            pg8::gemm_phase<EpiRes, pg8::StaticOrder, false>(lds, g, S, E, nullptr);
        }
    }
    if (!fuse_norm) SEAM(14);
    if (IN(15) && !fuse_norm) { phase_final(a.out, a.in[24], gw, NGW, lane); }
#ifdef EXTRA_SYNCS
    if (a.coop) for (int q_ = 0; q_ < EXTRA_SYNCS; ++q_) xcd_barrier(xbar);
#endif
#undef IN
#undef SEAM
}

#ifndef MK_PER_PHASE
#define MK_PER_PHASE 0
#endif

extern "C" void kernel_launch(void* const* d_in, const int* in_sizes, int n_in, void* d_out, int out_size, void* d_ws, size_t ws_size, hipStream_t stream) {
    static int grid = 0;
    if (grid == 0) {
        if (n_in != 25 || out_size != NTOK * DM || ws_size < WS_END) { fprintf(stderr, "kernel_launch: unexpected shapes (n_in %d out %d ws %zu)\n", n_in, out_size, ws_size); grid = -1; return; }
        int dev = 0, cus = 0, per_cu = 0;
        if (hipGetDevice(&dev) != hipSuccess || hipDeviceGetAttribute(&cus, hipDeviceAttributeMultiprocessorCount, dev) != hipSuccess) { grid = -1; return; }
        if (hipFuncSetAttribute((const void*)mk_fwd, hipFuncAttributeMaxDynamicSharedMemorySize, LDS_BYTES) != hipSuccess) { fprintf(stderr, "kernel_launch: hipFuncSetAttribute failed\n"); grid = -1; return; }
        if (hipOccupancyMaxActiveBlocksPerMultiprocessor(&per_cu, (const void*)mk_fwd, 512, LDS_BYTES) != hipSuccess || per_cu < 1) { fprintf(stderr, "kernel_launch: occupancy query says %d\n", per_cu); per_cu = 1; }
        (void)hipGetLastError();
        grid = cus;
    }
    if (grid < 0) return;
    Args a{};
    for (int i = 0; i < 25; ++i) a.in[i] = (const float*)d_in[i];
    a.out = (float*)d_out; a.ws = (unsigned char*)d_ws;
#if MK_PER_PHASE
    for (int p = 0; p < NPHASE; ++p) { a.ph_lo = p; a.ph_hi = p + 1; a.coop = 0;
        hipLaunchKernelGGL(mk_fwd, dim3(grid), dim3(512), LDS_BYTES, stream, a); }
#else
    if (hipMemsetAsync((char*)d_ws + WS_CTL, 0, 65536, stream) != hipSuccess) { fprintf(stderr, "kernel_launch: memset failed\n"); return; }
    a.ph_lo = 0; a.ph_hi = NPHASE; a.coop = 1;
    void* args[] = {&a};
    hipError_t e = hipLaunchCooperativeKernel((const void*)mk_fwd, dim3(grid), dim3(512), args, LDS_BYTES, stream);
    if (e != hipSuccess) fprintf(stderr, "cooperative launch failed: %s (grid %d)\n", hipGetErrorString(e), grid);
#endif
}
```

```cpp
#include <hip/hip_runtime.h>
#include <hip/hip_cooperative_groups.h>
#include <cstdio>
#include <cstdint>
namespace cg = cooperative_groups;
namespace pg8 {
#define PG8_LAS __attribute__((address_space(3)))
typedef unsigned short bf16_t;
typedef short bf16x8 __attribute__((ext_vector_type(8)));
typedef float f32x4 __attribute__((ext_vector_type(4)));
typedef unsigned u32x4 __attribute__((ext_vector_type(4)));
constexpr int BM = 256, BK = 64, HALF = 128, HTB = HALF * BK * 2  , STAGE_BYTES = 8 * HTB, NXCD = 8, WGM = 2;

__host__ __device__ __forceinline__ int lds_byte(int r, int c) { const int st = (r >> 4) * 2 + (c >> 5), rr = r & 15, cc = c & 31, ob = rr * 64 + cc * 2; return st * 1024 + (ob ^ (((ob >> 9) & 1) << 5)); }
__host__ __device__ __forceinline__ void stage_rc(int b, int& R, int& C) { const int st = b / 1024, sb = b % 1024, swz = sb ^ (((sb >> 9) & 1) << 5); R = (st >> 1) * 16 + swz / 64; C = (st & 1) * 32 + (swz % 64) / 2; }
__host__ __device__ __forceinline__ int perm32(int rho) { const int n = rho >> 4, i = rho & 15; return 8 * (i >> 2) + 4 * n + (i & 3); }

struct Unit { int pm, pn; };
struct Gemm { const bf16_t* A; const bf16_t* Bt; int M, N, K; };

struct StaticOrder {
    int nM, nN, nwg, G, c;
    __host__ __device__ void init(int M, int N, int G_, int c_) { nM = M / BM; nN = N / BM; nwg = nM * nN; G = G_; c = c_; }
    __host__ __device__ bool next(int i, Unit& u) const {
        const long L = (long)i * G + c; if (L >= nwg) return false;
        int wgid = (int)L; { const int q = nwg / NXCD, r = nwg % NXCD, xcd = wgid % NXCD, off = wgid / NXCD; wgid = (xcd < r ? xcd * (q + 1) : r * (q + 1) + (xcd - r) * q) + off; }
        const int nig = WGM * nN, gid = wgid / nig, fm = gid * WGM, gsz = (nM - fm) < WGM ? (nM - fm) : WGM;
        u.pm = fm + ((wgid % nig) % gsz); u.pn = (wgid % nig) / gsz; return true;
    }
    __device__ __forceinline__ void a_ready(const Unit&) const {}
    __device__ __forceinline__ void done(const Unit&) const {}
};
__device__ __forceinline__ unsigned cvt_pk_bf16(float lo, float hi) { unsigned r; asm volatile("v_cvt_pk_bf16_f32 %0, %1, %2" : "=v"(r) : "v"(lo), "v"(hi)); return r; }
template <class T, class = void> struct has_keep_acc { static constexpr bool value = false; };
template <class T> struct has_keep_acc<T, decltype((void)T::KEEP_ACC)> { static constexpr bool value = true; };
template <class Epi, class Sched, bool STAMP = false>
__device__ __forceinline__ void gemm_phase(PG8_LAS unsigned char* lds, const Gemm g, const Sched& S, const Epi& E, unsigned long long* stamps) {
    const int tid = threadIdx.x, wid = __builtin_amdgcn_readfirstlane(tid >> 6), lane = tid & 63, wr = wid >> 2, wc = wid & 3, fr = lane & 15, fq = lane >> 4;
    const int K = g.K, nt = K / BK;
    int ts_lo = 0, ts_hi = 0, nts = 0; const unsigned long long rt_entry = STAMP ? (unsigned long long)wall_clock64() : 0ull;
#define PG8_STAMP() do { if (STAMP && wid == 0 && nts < 64) { const unsigned long long _c = (unsigned long long)clock64(); \
        ts_lo = (lane == nts) ? (int)(unsigned)_c : ts_lo; ts_hi = (lane == nts) ? (int)(unsigned)(_c >> 32) : ts_hi; ++nts; } } while (0)
    PG8_STAMP();
    unsigned voffA[2], voffB[2];
#pragma unroll
    for (int i = 0; i < 2; ++i) { int R, C; stage_rc(tid * 16 + i * 8192, R, C); const int Rb = Epi::PERM ? ((R & ~31) + perm32(R & 31)) : R;
        voffA[i] = (unsigned)(R * K + C) * 2u; voffB[i] = (unsigned)(Rb * K + C) * 2u; }
    const size_t kstep = (size_t)(BK * 2);
    const size_t hstep = (size_t)HALF * K * 2;
    const size_t tstep = 2 * hstep;
    const unsigned ldsw = (unsigned)wid * 1024u;
    const int aoff = lds_byte(wr * 64 + fr, fq * 8), boff = lds_byte(wc * 32 + fr, fq * 8);
#define PG8_SA(b, h) (((b) * 2 + (h)) * HTB)
#define PG8_SB(b, h) ((4 + (b) * 2 + (h)) * HTB)
#define PG8_STAGE(bufoff, gbase, voff) do { _Pragma("unroll") for (int _i = 0; _i < 2; ++_i) \
        __builtin_amdgcn_global_load_lds((const unsigned*)((const char*)(gbase) + (voff)[_i]), (PG8_LAS unsigned*)(lds + (bufoff) + ldsw + _i * 8192), 16, 0, 0); } while (0)
#define PG8_LDA(dst, b, h) do { _Pragma("unroll") for (int m = 0; m < 4; ++m) _Pragma("unroll") for (int k = 0; k < 2; ++k) dst[m][k] = *(const PG8_LAS bf16x8*)(lds + PG8_SA(b, h) + aoff + m * 2048 + k * 1024); } while (0)
#define PG8_LDB(dst, b, h) do { _Pragma("unroll") for (int n = 0; n < 2; ++n) _Pragma("unroll") for (int k = 0; k < 2; ++k) dst[n][k] = *(const PG8_LAS bf16x8*)(lds + PG8_SB(b, h) + boff + n * 2048 + k * 1024); } while (0)
#define PG8_MMA(ai, bj, At, Bt) do { __builtin_amdgcn_s_setprio(1); _Pragma("unroll") for (int m = 0; m < 4; ++m) _Pragma("unroll") for (int n = 0; n < 2; ++n) _Pragma("unroll") for (int k = 0; k < 2; ++k) \
        acc[ai][bj][m][n] = __builtin_amdgcn_mfma_f32_16x16x32_bf16(Bt[n][k], At[m][k], acc[ai][bj][m][n], 0, 0, 0); __builtin_amdgcn_s_setprio(0); } while (0)
#define PG8_WAIT_V(n) asm volatile("s_waitcnt vmcnt(" #n ")" ::: "memory")
#define PG8_WAIT_L(n) asm volatile("s_waitcnt lgkmcnt(" #n ")" ::: "memory")
#define PG8_BAR __builtin_amdgcn_s_barrier()
#define PG8_SCHED __builtin_amdgcn_sched_barrier(0)
    Unit cur, nxt; int ui = 0;
    if (!S.next(0, cur)) return;
    f32x4 acc[2][2][4][2];
#pragma unroll
    for (int a = 0; a < 2; ++a)
#pragma unroll
        for (int b = 0; b < 2; ++b)
#pragma unroll
            for (int m = 0; m < 4; ++m)
#pragma unroll
                for (int n = 0; n < 2; ++n) acc[a][b][m][n] = (f32x4){0.f, 0.f, 0.f, 0.f};
    bf16x8 At[4][2], B0[2][2], B1[2][2];
    const char* cA = (const char*)g.A + (size_t)cur.pm * tstep; const char* cB = (const char*)g.Bt + (size_t)cur.pn * tstep;
    S.a_ready(cur);
    PG8_STAGE(PG8_SB(0, 0), cB, voffB); PG8_STAGE(PG8_SA(0, 0), cA, voffA); PG8_STAGE(PG8_SB(0, 1), cB + hstep, voffB); PG8_STAGE(PG8_SA(0, 1), cA + hstep, voffA);
    if (wr == 1) PG8_BAR;
    PG8_WAIT_V(4); PG8_BAR;
    PG8_STAGE(PG8_SB(1, 0), cB + kstep, voffB); PG8_STAGE(PG8_SA(1, 0), cA + kstep, voffA); PG8_STAGE(PG8_SB(1, 1), cB + hstep + kstep, voffB);
    PG8_WAIT_V(6); PG8_BAR;
    PG8_STAMP();
    for (;;) {
        const bool has_next = S.next(ui + 1, nxt);
        const char* nA = has_next ? (const char*)g.A + (size_t)nxt.pm * tstep : cA; const char* nB = has_next ? (const char*)g.Bt + (size_t)nxt.pn * tstep : cB;
        for (int t = 0; t < nt; t += 2) {
            const bool last = (t == nt - 2);
            const char* a1 = cA + (size_t)(t + 1) * kstep;
            const char* a2 = last ? nA : cA + (size_t)(t + 2) * kstep; const char* b2 = last ? nB : cB + (size_t)(t + 2) * kstep;
            const char* a3 = a2 + kstep; const char* b3 = b2 + kstep;
            if (last && has_next) S.a_ready(nxt);
            PG8_LDB(B0, 0, 0); PG8_SCHED; PG8_LDA(At, 0, 0); PG8_STAGE(PG8_SA(1, 1), a1 + hstep, voffA);
            PG8_WAIT_L(8); PG8_BAR; PG8_WAIT_L(0); PG8_MMA(0, 0, At, B0); PG8_BAR; PG8_SCHED;
            PG8_LDB(B1, 0, 1); PG8_STAGE(PG8_SB(0, 0), b2, voffB);
            PG8_BAR; PG8_WAIT_L(0); PG8_MMA(0, 1, At, B1); PG8_BAR;
            PG8_LDA(At, 0, 1); PG8_STAGE(PG8_SA(0, 0), a2, voffA);
            PG8_BAR; PG8_WAIT_L(0); PG8_MMA(1, 0, At, B0); PG8_BAR; PG8_SCHED;
            PG8_STAGE(PG8_SB(0, 1), b2 + hstep, voffB);
            PG8_WAIT_V(6); PG8_BAR; PG8_MMA(1, 1, At, B1); PG8_BAR;
            PG8_LDB(B0, 1, 0); PG8_SCHED; PG8_LDA(At, 1, 0); PG8_STAGE(PG8_SA(0, 1), a2 + hstep, voffA);
            PG8_WAIT_L(8); PG8_BAR; PG8_WAIT_L(0); PG8_MMA(0, 0, At, B0); PG8_BAR; PG8_SCHED;
            PG8_LDB(B1, 1, 1); PG8_STAGE(PG8_SB(1, 0), b3, voffB);
            PG8_BAR; PG8_WAIT_L(0); PG8_MMA(0, 1, At, B1); PG8_BAR;
            PG8_LDA(At, 1, 1); PG8_STAGE(PG8_SA(1, 0), a3, voffA);
            PG8_BAR; PG8_WAIT_L(0); PG8_MMA(1, 0, At, B0); PG8_BAR; PG8_SCHED;
            PG8_STAGE(PG8_SB(1, 1), b3 + hstep, voffB);
            PG8_WAIT_V(6); PG8_BAR; PG8_MMA(1, 1, At, B1); PG8_BAR;
        }
        PG8_STAMP();
        if constexpr (!Epi::AFTER_DRAIN) { E(acc, cur, wr, wc, fr, fq); S.done(cur); }
        PG8_STAMP();
        if (!has_next) break;
        bool keep = false;
        if constexpr (has_keep_acc<Epi>::value) keep = E.keep_acc(cur);
        if (!keep) {
#pragma unroll
        for (int a = 0; a < 2; ++a)
#pragma unroll
            for (int b = 0; b < 2; ++b)
#pragma unroll
                for (int m = 0; m < 4; ++m)
#pragma unroll
                    for (int n = 0; n < 2; ++n) acc[a][b][m][n] = (f32x4){0.f, 0.f, 0.f, 0.f};
        }
        cur = nxt; cA = nA; cB = nB; ++ui;
    }
    PG8_WAIT_V(0);
    if (wr == 0) PG8_BAR;
    PG8_BAR;
    if constexpr (Epi::AFTER_DRAIN) { E.fused(acc, cur, wr, wc, fr, fq, lds, wid, lane); S.done(cur); }
    PG8_STAMP();
    if (STAMP && wid == 0) { stamps[lane] = lane < nts ? (((unsigned long long)(unsigned)ts_hi << 32) | (unsigned)ts_lo) : 0ull;
        if (lane == 62) stamps[62] = rt_entry; if (lane == 63) stamps[63] = (unsigned long long)wall_clock64(); }
#undef PG8_STAMP
#undef PG8_SA
#undef PG8_SB
#undef PG8_STAGE
#undef PG8_LDA
#undef PG8_LDB
#undef PG8_MMA
#undef PG8_WAIT_V
#undef PG8_WAIT_L
#undef PG8_BAR
#undef PG8_SCHED
}
}

using pg8::bf16_t; using pg8::bf16x8; using pg8::f32x4; using pg8::u32x4; using pg8::Unit;
typedef unsigned u32x2 __attribute__((ext_vector_type(2)));

constexpr int DM = 1024, NB = 4, SEQL = 4096, NTOK = NB * SEQL, CTXL = 256, NCTX = NB * CTXL, MROWS = NTOK + NCTX;
constexpr int DFF = 2816, INCOLS = 8224, NH = 8, HD = 128;
constexpr int OFF_Q = 2080, OFF_Z = 3104, OFF_U = 4128, OFF_AV = 5152, OFF_GA = 6176, OFF_GB = 7200;
constexpr float EPS = 1e-6f;
constexpr int LDS_BYTES = 159744;
constexpr int NPHASE = 16;
#ifndef SCAN16
#define SCAN16 1
#endif
#ifndef USE_CHUNKED
#define USE_CHUNKED 1
#endif

constexpr size_t MiB = 1048576;
constexpr size_t WS_W1T = 0, WS_WAT = 16 * MiB + MiB / 2, WS_WBT = WS_WAT + 2 * MiB, WS_WOT = WS_WBT + 2 * MiB, WS_WUPT = WS_WOT + 2 * MiB, WS_WDT = WS_WUPT + 11 * MiB;
constexpr size_t WS_MOD = 39 * MiB, WS_BA = 39 * MiB + MiB / 4, WS_BETA = 41 * MiB + MiB / 2, WS_G = 42 * MiB + 3 * MiB / 4;
constexpr size_t WS_A1 = 44 * MiB;
constexpr size_t WS_R1 = 78 * MiB;
constexpr size_t WS_QRAW = WS_R1 + 68 * MiB;
constexpr size_t WS_TT = 78 * MiB, WS_QG = 112 * MiB;
constexpr size_t WS_OF = 146 * MiB, WS_OB = 178 * MiB;
constexpr size_t WS_ZS = 78 * MiB, WS_GA = 110 * MiB, WS_GB = 210 * MiB;
constexpr size_t WS_AA = WS_A1;
constexpr size_t WS_T1 = 78 * MiB, WS_MG = 110 * MiB;
constexpr size_t WS_QN = 210 * MiB;
constexpr size_t WS_KNC = 242 * MiB, WS_VNC = 244 * MiB, WS_GC = 246 * MiB;
constexpr size_t WS_CTL = 248 * MiB;
constexpr size_t WS_XB = 248 * MiB + 65536;
constexpr size_t WS_END = 248 * MiB + 65536 + 262144;

typedef __bf16 bf16v2_t __attribute__((ext_vector_type(2)));
typedef float f32v2_t __attribute__((ext_vector_type(2)));
__device__ __forceinline__ unsigned cvt2(float a, float b) { f32v2_t v = {a, b}; bf16v2_t r = __builtin_convertvector(v, bf16v2_t); return __builtin_bit_cast(unsigned, r); }
__device__ __forceinline__ unsigned f2bf(float f) { return cvt2(f, f) & 0xffffu; }
__device__ __forceinline__ unsigned pk2(float lo, float hi) { return cvt2(lo, hi); }
__device__ __forceinline__ float bflo(unsigned w) { return __uint_as_float(w << 16); }
__device__ __forceinline__ float bfhi(unsigned w) { return __uint_as_float(w & 0xffff0000u); }
__device__ __forceinline__ float bf1(bf16_t b) { return __uint_as_float(((unsigned)b) << 16); }
__device__ __forceinline__ float sigmoidf_(float x) { return __builtin_amdgcn_rcpf(1.0f + __builtin_amdgcn_exp2f(-1.4426950408889634f * x)); }
__device__ __forceinline__ float siluf_(float x) { return x * sigmoidf_(x); }
__device__ __forceinline__ float geluf_(float x) { const float u = x * (2.3022082f + 0.10294324f * x * x); return x * __builtin_amdgcn_rcpf(1.0f + __builtin_amdgcn_exp2f(-u)); }
__device__ __forceinline__ float act_apply(float x, int act) { return act == 1 ? geluf_(x) : (act == 2 ? siluf_(x) : (act == 3 ? sigmoidf_(x) : x)); }
__device__ __forceinline__ float wave_sum(float v) {
#pragma unroll
    for (int o = 1; o < 64; o <<= 1) v += __shfl_xor(v, o);
    return v;
}
#define LDS_WAIT() asm volatile("s_waitcnt lgkmcnt(0)" ::: "memory")

struct EpiSel {
    static constexpr bool PERM = true, AFTER_DRAIN = false;
    bf16_t *O0, *O1, *O2, *O3, *O4; int ld0, ld1, ld2, ld3, ld4; int a0, a1, a2, a3, a4; int ba_pn; float* BA;
    __device__ __forceinline__ void operator()(const f32x4 (&acc)[2][2][4][2], const Unit& u, int wr, int wc, int fr, int fq) const {
        asm volatile("" : "+v"(fr), "+v"(fq));
        const int row0 = u.pm * 256 + wr * 64 + fr;
        if (u.pn == ba_pn) {
            if (wc == 0) {
#pragma unroll
                for (int ai = 0; ai < 2; ++ai)
#pragma unroll
                    for (int m = 0; m < 4; ++m) { float* rp = BA + (size_t)(row0 + ai * 128 + m * 16) * 32 + 8 * fq;
#pragma unroll
                        for (int n = 0; n < 2; ++n) *(f32x4*)(rp + 4 * n) = acc[ai][0][m][n]; }
            }
            return;
        }
        const int g = u.pn >> 2;
        bf16_t* O = g == 0 ? O0 : (g == 1 ? O1 : (g == 2 ? O2 : (g == 3 ? O3 : O4)));
        const int ldc = g == 0 ? ld0 : (g == 1 ? ld1 : (g == 2 ? ld2 : (g == 3 ? ld3 : ld4)));
        const int act = g == 0 ? a0 : (g == 1 ? a1 : (g == 2 ? a2 : (g == 3 ? a3 : a4)));
        const int col0 = (u.pn & 3) * 256 + wc * 32 + 8 * fq;
        bf16_t* Ob = O + (size_t)row0 * ldc + col0;
        if (act == 0) store_tile<0>(acc, Ob, ldc); else if (act == 1) store_tile<1>(acc, Ob, ldc); else if (act == 2) store_tile<2>(acc, Ob, ldc); else store_tile<3>(acc, Ob, ldc);
    }
    template <int ACT> __device__ __forceinline__ void store_tile(const f32x4 (&acc)[2][2][4][2], bf16_t* Ob, int ldc) const {
#pragma unroll
        for (int ai = 0; ai < 2; ++ai)
#pragma unroll
            for (int m = 0; m < 4; ++m) { bf16_t* rowp = Ob + (size_t)(ai * 128 + m * 16) * ldc;
#pragma unroll
                for (int bj = 0; bj < 2; ++bj) { f32x4 v0 = acc[ai][bj][m][0], v1 = acc[ai][bj][m][1];
                    if (ACT) {
#pragma unroll
                        for (int j = 0; j < 4; ++j) { float x0 = v0[j], x1 = v1[j];
                            if (ACT == 3) asm volatile("" : "+v"(x0), "+v"(x1));
                            v0[j] = ACT == 1 ? geluf_(x0) : (ACT == 2 ? siluf_(x0) : sigmoidf_(x0)); v1[j] = ACT == 1 ? geluf_(x1) : (ACT == 2 ? siluf_(x1) : sigmoidf_(x1)); } }
                    u32x4 w; w.x = pk2(v0[0], v0[1]); w.y = pk2(v0[2], v0[3]); w.z = pk2(v1[0], v1[1]); w.w = pk2(v1[2], v1[3]);
                    *(u32x4*)(rowp + bj * 128) = w; } }
    }
};
struct EpiGate {
    static constexpr bool PERM = true, AFTER_DRAIN = false;
    const bf16_t* G; const bf16_t* T; bf16_t* O;
    __device__ __forceinline__ void operator()(const f32x4 (&acc)[2][2][4][2], const Unit& u, int wr, int wc, int fr, int fq) const {
        asm volatile("" : "+v"(fr), "+v"(fq));
        const int row0 = u.pm * 256 + wr * 64 + fr, col0 = u.pn * 256 + wc * 32 + 8 * fq;
        const size_t off0 = (size_t)row0 * DM + col0;
        const u32x4 z4 = (u32x4){0u, 0u, 0u, 0u};
#pragma unroll
        for (int ai = 0; ai < 2; ++ai)
#pragma unroll
          for (int mp = 0; mp < 2; ++mp) {
            u32x4 gw[2][2], tw[2][2];
#pragma unroll
            for (int mm = 0; mm < 2; ++mm)
#pragma unroll
                for (int bj = 0; bj < 2; ++bj) { const size_t off = off0 + (size_t)(ai * 128 + (2 * mp + mm) * 16) * DM + bj * 128;
                    gw[mm][bj] = *(const u32x4*)(G + off); tw[mm][bj] = T ? *(const u32x4*)(T + off) : z4; }
#pragma unroll
            for (int mm = 0; mm < 2; ++mm)
#pragma unroll
                for (int bj = 0; bj < 2; ++bj) { const int m = 2 * mp + mm; const size_t off = off0 + (size_t)(ai * 128 + m * 16) * DM + bj * 128;
                    const f32x4 v0 = acc[ai][bj][m][0], v1 = acc[ai][bj][m][1]; const u32x4 g = gw[mm][bj], t = tw[mm][bj];
                    float r[8];
                    r[0] = v0[0] * bflo(g.x) + bflo(t.x); r[1] = v0[1] * bfhi(g.x) + bfhi(t.x); r[2] = v0[2] * bflo(g.y) + bflo(t.y); r[3] = v0[3] * bfhi(g.y) + bfhi(t.y);
                    r[4] = v1[0] * bflo(g.z) + bflo(t.z); r[5] = v1[1] * bfhi(g.z) + bfhi(t.z); r[6] = v1[2] * bflo(g.w) + bflo(t.w); r[7] = v1[3] * bfhi(g.w) + bfhi(t.w);
                    u32x4 w; w.x = pk2(r[0], r[1]); w.y = pk2(r[2], r[3]); w.z = pk2(r[4], r[5]); w.w = pk2(r[6], r[7]);
                    *(u32x4*)(O + off) = w; }
          }
    }
};
struct OrderAB {
    pg8::StaticOrder S0;
    __device__ bool next(int i, Unit& u) const { if (!S0.next(i >> 1, u)) return false; if (i & 1) { u.pm += 204; u.pn += 4; } return true; }
    __device__ __forceinline__ void a_ready(const Unit&) const {}
    __device__ __forceinline__ void done(const Unit&) const {}
};
struct EpiGateAB {
    static constexpr bool PERM = true, AFTER_DRAIN = false, KEEP_ACC = true;
    const bf16_t *GAp, *GBp; bf16_t* MGp;
    __device__ __forceinline__ bool keep_acc(const Unit& u) const { return u.pn < 4; }
    __device__ __forceinline__ void operator()(f32x4 (&acc)[2][2][4][2], const Unit& u, int wr, int wc, int fr, int fq) const {
        asm volatile("" : "+v"(fr), "+v"(fq));
        const bool first = u.pn < 4; const int pm = first ? u.pm : u.pm - 204, pn = first ? u.pn : u.pn - 4;
        const int row0 = pm * 256 + wr * 64 + fr, col0 = pn * 256 + wc * 32 + 8 * fq;
        const size_t off0 = (size_t)row0 * DM + col0;
#pragma unroll
        for (int ai = 0; ai < 2; ++ai)
#pragma unroll
          for (int mp = 0; mp < 2; ++mp) {
            u32x4 gb[2][2], ga[2][2];
#pragma unroll
            for (int mm = 0; mm < 2; ++mm)
#pragma unroll
                for (int bj = 0; bj < 2; ++bj) { const size_t off = off0 + (size_t)(ai * 128 + (2 * mp + mm) * 16) * DM + bj * 128;
                    gb[mm][bj] = *(const u32x4*)(GBp + off); ga[mm][bj] = first ? *(const u32x4*)(GAp + off) : (u32x4){0u, 0u, 0u, 0u}; }
#pragma unroll
            for (int mm = 0; mm < 2; ++mm)
#pragma unroll
                for (int bj = 0; bj < 2; ++bj) { const int m = 2 * mp + mm; const u32x4 b = gb[mm][bj], a = ga[mm][bj];
                    const float bv[8] = {bflo(b.x), bfhi(b.x), bflo(b.y), bfhi(b.y), bflo(b.z), bfhi(b.z), bflo(b.w), bfhi(b.w)};
                    if (first) {
                        const float av[8] = {bflo(a.x), bfhi(a.x), bflo(a.y), bfhi(a.y), bflo(a.z), bfhi(a.z), bflo(a.w), bfhi(a.w)};
#pragma unroll
                        for (int e = 0; e < 4; ++e) { acc[ai][bj][m][0][e] *= av[e] * __builtin_amdgcn_rcpf(bv[e]); acc[ai][bj][m][1][e] *= av[4 + e] * __builtin_amdgcn_rcpf(bv[4 + e]); }
                    } else {
                        const f32x4 v0 = acc[ai][bj][m][0], v1 = acc[ai][bj][m][1];
                        u32x4 w; w.x = pk2(v0[0] * bv[0], v0[1] * bv[1]); w.y = pk2(v0[2] * bv[2], v0[3] * bv[3]); w.z = pk2(v1[0] * bv[4], v1[1] * bv[5]); w.w = pk2(v1[2] * bv[6], v1[3] * bv[7]);
                        *(u32x4*)(MGp + off0 + (size_t)(ai * 128 + m * 16) * DM + bj * 128) = w; }
                }
          }
    }
};
struct EpiRes {
    static constexpr bool PERM = false, AFTER_DRAIN = false;
    const float* base; float* out; const float* gate;
    __device__ __forceinline__ void operator()(const f32x4 (&acc)[2][2][4][2], const Unit& u, int wr, int wc, int fr, int fq) const {
        asm volatile("" : "+v"(fr), "+v"(fq));
        const int row0 = u.pm * 256 + wr * 64 + fr, col0 = u.pn * 256 + wc * 32 + 4 * fq;
        const float* gp = gate + (size_t)(u.pm >> 4) * 6144 + col0;
        f32x4 gv[2][2];
#pragma unroll
        for (int bj = 0; bj < 2; ++bj)
#pragma unroll
            for (int n = 0; n < 2; ++n) gv[bj][n] = *(const f32x4*)(gp + bj * 128 + n * 16);
#pragma unroll
        for (int ai = 0; ai < 2; ++ai)
#pragma unroll
            for (int mp = 0; mp < 2; ++mp) {
                f32x4 bs[2][2][2];
#pragma unroll
                for (int mm = 0; mm < 2; ++mm)
#pragma unroll
                    for (int bj = 0; bj < 2; ++bj)
#pragma unroll
                        for (int n = 0; n < 2; ++n) bs[mm][bj][n] = *(const f32x4*)(base + (size_t)(row0 + ai * 128 + (2 * mp + mm) * 16) * DM + col0 + bj * 128 + n * 16);
#pragma unroll
                for (int mm = 0; mm < 2; ++mm)
#pragma unroll
                    for (int bj = 0; bj < 2; ++bj)
#pragma unroll
                        for (int n = 0; n < 2; ++n) *(f32x4*)(out + (size_t)(row0 + ai * 128 + (2 * mp + mm) * 16) * DM + col0 + bj * 128 + n * 16) = bs[mm][bj][n] + gv[bj][n] * acc[ai][bj][2 * mp + mm][n];
            }
    }
};
template <int MODE> struct EpiResNorm {
    static constexpr bool PERM = false, AFTER_DRAIN = true;
    const float* base; float* out; const float* gate; const float* ng; const float* mod; int sh_off, sc_off; bf16_t* hb; float* xbuf; unsigned* cnt;
    __device__ __forceinline__ void fused(f32x4 (&acc)[2][2][4][2], const Unit& u, int wr, int wc, int fr, int fq, PG8_LAS unsigned char* lds, int wid, int lane) const {
        asm volatile("" : "+v"(fr), "+v"(fq));
        PG8_LAS float* P = (PG8_LAS float*)lds;
        PG8_LAS float* Srs = (PG8_LAS float*)(lds + 8192);
        const int row0 = u.pm * 256 + wr * 64 + fr, col0 = u.pn * 256 + wc * 32 + 4 * fq;
        const float* gp = gate + (size_t)(u.pm >> 4) * 6144 + col0;
        f32x4 gv[2][2];
#pragma unroll
        for (int bj = 0; bj < 2; ++bj)
#pragma unroll
            for (int n = 0; n < 2; ++n) gv[bj][n] = *(const f32x4*)(gp + bj * 128 + n * 16);
#pragma unroll
        for (int ai = 0; ai < 2; ++ai)
#pragma unroll
            for (int mp = 0; mp < 2; ++mp) {
                f32x4 bs[2][2][2];
#pragma unroll
                for (int mm = 0; mm < 2; ++mm)
#pragma unroll
                    for (int bj = 0; bj < 2; ++bj)
#pragma unroll
                        for (int n = 0; n < 2; ++n) bs[mm][bj][n] = *(const f32x4*)(base + (size_t)(row0 + ai * 128 + (2 * mp + mm) * 16) * DM + col0 + bj * 128 + n * 16);
#pragma unroll
                for (int mm = 0; mm < 2; ++mm) { const int m = 2 * mp + mm; float ss = 0.f;
#pragma unroll
                    for (int bj = 0; bj < 2; ++bj)
#pragma unroll
                        for (int n = 0; n < 2; ++n) { const f32x4 x = bs[mm][bj][n] + gv[bj][n] * acc[ai][bj][m][n]; acc[ai][bj][m][n] = x;
                            if (MODE == 1) *(f32x4*)(out + (size_t)(row0 + ai * 128 + m * 16) * DM + col0 + bj * 128 + n * 16) = x;
                            ss += (x[0] * x[0] + x[1] * x[1]) + (x[2] * x[2] + x[3] * x[3]); }
                    ss += __shfl_xor(ss, 16); ss += __shfl_xor(ss, 32);
                    if (fq == 0) P[(ai * 128 + wr * 64 + m * 16 + fr) * 4 + wc] = ss; }
            }
        asm volatile("s_waitcnt lgkmcnt(0)" ::: "memory"); __builtin_amdgcn_s_barrier(); asm volatile("" ::: "memory");
        const int row = wid * 32 + (lane & 31);
        if (lane < 32) { const float t = (P[row * 4 + 0] + P[row * 4 + 1]) + (P[row * 4 + 2] + P[row * 4 + 3]);
            __hip_atomic_store(xbuf + ((size_t)(u.pm * 256 + row) * 4 + u.pn), t, __ATOMIC_RELAXED, __HIP_MEMORY_SCOPE_AGENT); }
        asm volatile("s_waitcnt vmcnt(0)" ::: "memory");
        if (lane == 0) __hip_atomic_fetch_add(cnt + 64 * u.pm, 1u, __ATOMIC_RELAXED, __HIP_MEMORY_SCOPE_AGENT);
        if (wid == 0) { unsigned sp = 0;
            while ((unsigned)__builtin_amdgcn_readfirstlane(__hip_atomic_load(cnt + 64 * u.pm, __ATOMIC_RELAXED, __HIP_MEMORY_SCOPE_AGENT)) < 32u) { __builtin_amdgcn_s_sleep(2); if (++sp > (1u << 24)) break; }
            __builtin_amdgcn_fence(__ATOMIC_ACQUIRE, "agent"); }
        asm volatile("s_waitcnt vmcnt(0) lgkmcnt(0)" ::: "memory"); __builtin_amdgcn_s_barrier(); asm volatile("" ::: "memory");
        if (lane < 32) { const float* sl = xbuf + (size_t)(u.pm * 256 + row) * 4; float t = 0.f;
#pragma unroll
            for (int q = 0; q < 4; ++q) t += __hip_atomic_load(sl + q, __ATOMIC_RELAXED, __HIP_MEMORY_SCOPE_AGENT);
            Srs[row] = 1.0f / sqrtf(t * (1.0f / DM) + EPS); }
        asm volatile("s_waitcnt vmcnt(0) lgkmcnt(0)" ::: "memory"); __builtin_amdgcn_s_barrier(); asm volatile("" ::: "memory");
        f32x4 gg[2][2], sh[2][2], sc[2][2];
#pragma unroll
        for (int bj = 0; bj < 2; ++bj)
#pragma unroll
            for (int n = 0; n < 2; ++n) { const int c = col0 + bj * 128 + n * 16; gg[bj][n] = *(const f32x4*)(ng + c);
                if (MODE == 1) { const float* mp_ = mod + (size_t)(u.pm >> 4) * 6144; sh[bj][n] = *(const f32x4*)(mp_ + sh_off + c); sc[bj][n] = *(const f32x4*)(mp_ + sc_off + c); } }
#pragma unroll
        for (int ai = 0; ai < 2; ++ai)
#pragma unroll
            for (int m = 0; m < 4; ++m) { const int rl = ai * 128 + wr * 64 + m * 16 + fr; const float rs = Srs[rl]; const size_t off = (size_t)(u.pm * 256 + rl) * DM + col0;
#pragma unroll
                for (int bj = 0; bj < 2; ++bj)
#pragma unroll
                    for (int n = 0; n < 2; ++n) { const f32x4 y = acc[ai][bj][m][n] * rs * gg[bj][n];
                        if (MODE == 0) *(f32x4*)(out + off + bj * 128 + n * 16) = y;
                        else { const f32x4 hv = y * (1.0f + sc[bj][n]) + sh[bj][n]; u32x2 w; w.x = pk2(hv[0], hv[1]); w.y = pk2(hv[2], hv[3]); *(u32x2*)(hb + off + bj * 128 + n * 16) = w; } } }
    }
};

struct EpiUp {
    static constexpr bool PERM = true, AFTER_DRAIN = false;
    const float* cw; const float* cb; bf16_t* ACT;
    __device__ __forceinline__ void operator()(const f32x4 (&acc)[2][2][4][2], const Unit& u, int wr, int wc, int fr, int fq) const {
        asm volatile("" : "+v"(fr), "+v"(fq));
        const int lane = (int)(threadIdx.x & 63);
        const int chb = u.pn * 128 + wc * 32 + 8 * fq;
        const int row0 = u.pm * 256 + wr * 64 + fr;
        f32x4 w0[2], w1[2], w2[2], bb[2];
#pragma unroll
        for (int n = 0; n < 2; ++n) { w0[n] = *(const f32x4*)(cw + chb + 4 * n); w1[n] = *(const f32x4*)(cw + DFF + chb + 4 * n); w2[n] = *(const f32x4*)(cw + 2 * DFF + chb + 4 * n); bb[n] = *(const f32x4*)(cb + chb + 4 * n); }
#pragma unroll
        for (int ai = 0; ai < 2; ++ai)
#pragma unroll
            for (int m = 0; m < 4; ++m) {
                float r[8];
#pragma unroll
                for (int n = 0; n < 2; ++n)
#pragma unroll
                    for (int e = 0; e < 4; ++e) {
                        const float cur = acc[ai][0][m][n][e];
                        const float pv_same = __int_as_float(__builtin_amdgcn_update_dpp(0, __float_as_int(cur), 0x111, 0xf, 0xf, true));
                        const float pv_wrap = (m > 0) ? __int_as_float(__builtin_amdgcn_update_dpp(0, __float_as_int(acc[ai][0][m > 0 ? m - 1 : 0][n][e]), 0x121, 0xf, 0xf, true)) : 0.f;
                        const float nx_same = __int_as_float(__builtin_amdgcn_update_dpp(0, __float_as_int(cur), 0x101, 0xf, 0xf, true));
                        const float nx_wrap = (m < 3) ? __int_as_float(__builtin_amdgcn_update_dpp(0, __float_as_int(acc[ai][0][m < 3 ? m + 1 : 3][n][e]), 0x12F, 0xf, 0xf, true)) : 0.f;
                        const float prev = fr > 0 ? pv_same : pv_wrap;
                        const float next = fr < 15 ? nx_same : nx_wrap;
                        const float a = w0[n][e] * prev + w1[n][e] * cur + w2[n][e] * next + bb[n][e];
                        r[n * 4 + e] = geluf_(a) * acc[ai][1][m][n][e];
                    }
                u32x4 w; w.x = pk2(r[0], r[1]); w.y = pk2(r[2], r[3]); w.z = pk2(r[4], r[5]); w.w = pk2(r[6], r[7]);
                *(u32x4*)(ACT + (size_t)(row0 + ai * 128 + m * 16) * DFF + chb) = w;
            }
    }
};

struct Order1a {
    int G, c;
    __device__ bool next(int i, Unit& u) const {
        const int L = i * G + c;
        if (L < 64 * 13) { const int grp = L / 104, r = L % 104; u.pm = grp * 8 + (r & 7); u.pn = r >> 3; return true; }
        const int r = L - 64 * 13; if (r >= 36) return false;
        u.pm = 64 + (r & 3); const int q = r >> 2; u.pn = q < 8 ? q : 12; return true;
    }
    __device__ __forceinline__ void a_ready(const Unit&) const {}
    __device__ __forceinline__ void done(const Unit&) const {}
};

struct Args { const float* in[25]; float* out; unsigned char* ws; int ph_lo, ph_hi, coop, pad; };

__device__ __forceinline__ void transpose_item(const float* __restrict__ W, int N, int srccol0, int k0, bf16_t* WT, int K, int drow0, float* scr, int lane) {
    if (srccol0 >= 0) {
        float tv[32];
#pragma unroll
        for (int i = 0; i < 32; ++i) { const int kk = 2 * i + (lane >> 5); tv[i] = W[(size_t)(k0 + kk) * N + srccol0 + (lane & 31)]; }
#pragma unroll
        for (int i = 0; i < 32; ++i) { const int kk = 2 * i + (lane >> 5); scr[kk * 33 + (lane & 31)] = tv[i]; }
    } else {
#pragma unroll 8
        for (int i = 0; i < 32; ++i) { const int kk = 2 * i + (lane >> 5); scr[kk * 33 + (lane & 31)] = 0.f; }
    }
    LDS_WAIT();
    const int c = lane & 7;
#pragma unroll
    for (int j = 0; j < 4; ++j) { const int n = (lane >> 3) + 8 * j; const float* s = scr + (8 * c) * 33 + n;
        u32x4 o; o.x = pk2(s[0 * 33], s[1 * 33]); o.y = pk2(s[2 * 33], s[3 * 33]); o.z = pk2(s[4 * 33], s[5 * 33]); o.w = pk2(s[6 * 33], s[7 * 33]);
        *(u32x4*)(WT + (size_t)(drow0 + n) * K + k0 + 8 * c) = o; }
    LDS_WAIT();
}

__device__ __forceinline__ int w1t_srccol(int nb) {
    if (nb < 64) return nb * 32;
    if (nb < 96) return OFF_Q + (nb - 64) * 32;
    if (nb == 96) return 2048;
    if (nb < 104) return -1;
    if (nb < 136) return OFF_U + (nb - 104) * 32;
    if (nb < 168) return OFF_AV + (nb - 136) * 32;
    if (nb < 200) return OFF_Z + (nb - 168) * 32;
    if (nb < 232) return OFF_GA + (nb - 200) * 32;
    return OFF_GB + (nb - 232) * 32;
}

__device__ __forceinline__ void phase0(const Args& a, unsigned char* shm, int gw, int NGW, int wave, int lane, int tid) {
    unsigned char* ws = a.ws;
    float* scr = (float*)(shm + wave * 16384);
    constexpr int I1 = 264 * 16, IA = 32 * 16, IU = 176 * 16, ID = 32 * 44;
    constexpr int NIT = I1 + 3 * IA + IU + ID;
    for (int it = gw; it < NIT; it += NGW) {
        int r = it;
        if (r < I1) { const int nb = r >> 4, kb = r & 15; transpose_item(a.in[7], INCOLS, w1t_srccol(nb), kb * 64, (bf16_t*)(ws + WS_W1T), DM, nb * 32, scr, lane); continue; } r -= I1;
        if (r < IA) { const int nb = r >> 4, kb = r & 15; transpose_item(a.in[17], DM, nb * 32, kb * 64, (bf16_t*)(ws + WS_WAT), DM, nb * 32, scr, lane); continue; } r -= IA;
        if (r < IA) { const int nb = r >> 4, kb = r & 15; transpose_item(a.in[12], DM, nb * 32, kb * 64, (bf16_t*)(ws + WS_WBT), DM, nb * 32, scr, lane); continue; } r -= IA;
        if (r < IA) { const int nb = r >> 4, kb = r & 15; transpose_item(a.in[18], DM, nb * 32, kb * 64, (bf16_t*)(ws + WS_WOT), DM, nb * 32, scr, lane); continue; } r -= IA;
        if (r < IU) { const int nb = r >> 4, kb = r & 15; const int j = nb >> 3, wi = nb & 7; const int sc = wi < 4 ? (128 * j + 32 * wi) : (DFF + 128 * j + 32 * (wi - 4));
            transpose_item(a.in[20], 2 * DFF, sc, kb * 64, (bf16_t*)(ws + WS_WUPT), DM, nb * 32, scr, lane); continue; } r -= IU;
        { const int nb = r / 44, kb = r % 44; transpose_item(a.in[23], DM, nb * 32, kb * 64, (bf16_t*)(ws + WS_WDT), DFF, nb * 32, scr, lane); }
    }
    __syncthreads();
    float* red = (float*)shm;
    float* sil = (float*)(shm + 16384);
    const float* wm = a.in[4]; const float* bm = a.in[5]; const float* cin = a.in[1]; const float* cctx = a.in[3];
    float* MOD = (float*)(ws + WS_MOD);
    if ((int)blockIdx.x < 192) {
        for (int i = tid; i < 5 * 1024; i += 512) { const float cv = i < 4096 ? cin[i] : cctx[i - 4096]; sil[i] = siluf_(cv); }
    }
    __syncthreads();
    for (int it = blockIdx.x; it < 192; it += gridDim.x) {
        const int c = tid & 31, kq = tid >> 5, col0 = it * 32;
        float s0 = 0.f, s1 = 0.f, s2 = 0.f, s3 = 0.f, s4 = 0.f;
#pragma unroll 16
        for (int kk = 0; kk < 64; ++kk) { const int k = kq * 64 + kk; const float w = wm[(size_t)k * 6144 + col0 + c];
            s0 += sil[k] * w; s1 += sil[1024 + k] * w; s2 += sil[2048 + k] * w; s3 += sil[3072 + k] * w; s4 += sil[4096 + k] * w; }
        red[(kq * 5 + 0) * 32 + c] = s0; red[(kq * 5 + 1) * 32 + c] = s1; red[(kq * 5 + 2) * 32 + c] = s2; red[(kq * 5 + 3) * 32 + c] = s3; red[(kq * 5 + 4) * 32 + c] = s4;
        __syncthreads();
        if (tid < 160) { const int b = tid >> 5, cc = tid & 31; float sv = 0.f;
            for (int q = 0; q < 16; ++q) sv += red[(q * 5 + b) * 32 + cc];
            MOD[b * 6144 + col0 + cc] = sv + bm[col0 + cc]; }
        __syncthreads();
    }
}

__device__ __forceinline__ void norm_mod_rows(const float* X, int nx, const float* X2, int n2, const float* g, const float* MOD, int sh_off, int sc_off, bf16_t* out, int gw, int NGW, int lane) {
    for (int r0 = gw; r0 < nx + n2; r0 += 2 * NGW) {
        const int r1 = r0 + NGW; const bool has1 = r1 < nx + n2; const int rr[2] = {r0, has1 ? r1 : r0};
        f32x4 v[2][4]; float ss[2];
#pragma unroll
        for (int u = 0; u < 2; ++u) { const int r = rr[u]; const float* src = r < nx ? X + (size_t)r * DM : X2 + (size_t)(r - nx) * DM;
#pragma unroll
            for (int j = 0; j < 4; ++j) v[u][j] = *(const f32x4*)(src + 4 * lane + 256 * j); }
#pragma unroll
        for (int u = 0; u < 2; ++u) { float s_ = 0.f;
#pragma unroll
            for (int j = 0; j < 4; ++j) s_ += (v[u][j][0] * v[u][j][0] + v[u][j][1] * v[u][j][1]) + (v[u][j][2] * v[u][j][2] + v[u][j][3] * v[u][j][3]);
            ss[u] = wave_sum(s_); }
#pragma unroll
        for (int u = 0; u < 2; ++u) { if (u == 1 && !has1) break;
            const int r = rr[u]; const int mb = r < nx ? (r >> 12) : 4;
            const float rs = 1.0f / sqrtf(ss[u] * (1.0f / DM) + EPS);
            const float* mp = MOD + (size_t)mb * 6144;
#pragma unroll
            for (int j = 0; j < 4; ++j) { const int col = 4 * lane + 256 * j;
                const f32x4 gg = *(const f32x4*)(g + col), sh = *(const f32x4*)(mp + sh_off + col), sc = *(const f32x4*)(mp + sc_off + col);
                const f32x4 y = v[u][j] * rs * gg; const f32x4 h = y * (1.0f + sc) + sh;
                u32x2 w; w.x = pk2(h[0], h[1]); w.y = pk2(h[2], h[3]);
                *(u32x2*)(out + (size_t)r * DM + col) = w; } }
    }
}

__device__ __forceinline__ void phase_branch_a(const Args& a, unsigned char* shm, const bf16_t* UG, const bf16_t* VG, bf16_t* AA, int wave, int lane, int tid) {
    bf16_t* VnT = (bf16_t*)shm;
    bf16_t* WsL = VnT + 128 * 136;
    float* stat = (float*)(shm + 2 * 128 * 136 * 2);
    const float* ln_g = a.in[13]; const float* ln_b = a.in[14]; const float* a_ws = a.in[15]; const float* a_bs = a.in[16];
    for (int it = blockIdx.x; it < 256; it += gridDim.x) {
        const int chunk = it >> 1, gh = it & 1, tok0 = chunk * 128;
        for (int tt = 0; tt < 16; ++tt) { const int t = wave * 16 + tt; const bf16_t* row = VG + (size_t)(tok0 + t) * DM + lane * 16;
            const u32x4 p0 = *(const u32x4*)row, p1 = *(const u32x4*)(row + 8);
            const unsigned w8[8] = {p0.x, p0.y, p0.z, p0.w, p1.x, p1.y, p1.z, p1.w};
            float s = 0.f, q = 0.f;
#pragma unroll
            for (int e = 0; e < 8; ++e) { const float x0 = bflo(w8[e]), x1 = bfhi(w8[e]); s += x0 + x1; q += x0 * x0 + x1 * x1; }
            s = wave_sum(s); q = wave_sum(q);
            const float mean = s * (1.0f / DM); const float var = q * (1.0f / DM) - mean * mean;
            if (lane == 0) { stat[2 * t] = mean; stat[2 * t + 1] = 1.0f / sqrtf(fmaxf(var, 0.f) + EPS); }
        }
        __syncthreads();
        for (int gi = 0; gi < 4; ++gi) {
            const int g = gh * 4 + gi;
            { const int j = tid >> 2, cq = (tid & 3) * 32; const float mean = stat[2 * j], rstd = stat[2 * j + 1];
              const bf16_t* src = VG + (size_t)(tok0 + j) * DM + g * 128 + cq;
#pragma unroll
              for (int v4 = 0; v4 < 4; ++v4) { const u32x4 p = *(const u32x4*)(src + 8 * v4); const unsigned w4[4] = {p.x, p.y, p.z, p.w};
#pragma unroll
                  for (int e = 0; e < 4; ++e) { const int cl = cq + 8 * v4 + 2 * e; const int ch = g * 128 + cl;
                      const float y0 = (bflo(w4[e]) - mean) * rstd * ln_g[ch] + ln_b[ch], y1 = (bfhi(w4[e]) - mean) * rstd * ln_g[ch + 1] + ln_b[ch + 1];
                      VnT[cl * 136 + j] = (bf16_t)f2bf(y0); VnT[(cl + 1) * 136 + j] = (bf16_t)f2bf(y1); } }
              const int i = tid >> 2, jq = (tid & 3) * 32; const float* wsrc = a_ws + ((size_t)g * 128 + i) * 128 + jq;
#pragma unroll
              for (int v4 = 0; v4 < 4; ++v4) { const f32x4 x0 = *(const f32x4*)(wsrc + 8 * v4), x1 = *(const f32x4*)(wsrc + 8 * v4 + 4);
                  u32x4 o; o.x = pk2(x0[0], x0[1]); o.y = pk2(x0[2], x0[3]); o.z = pk2(x1[0], x1[1]); o.w = pk2(x1[2], x1[3]);
                  *(u32x4*)(WsL + i * 136 + jq + 8 * v4) = o; }
            }
            __syncthreads();
            const int cb = (wave >> 1) * 32, ib = (wave & 1) * 64, lr = lane & 15, lq = lane >> 4;
            f32x4 acc[2][4];
#pragma unroll
            for (int m = 0; m < 2; ++m)
#pragma unroll
                for (int n = 0; n < 4; ++n) acc[m][n] = (f32x4){0.f, 0.f, 0.f, 0.f};
#pragma unroll
            for (int ks = 0; ks < 4; ++ks) { bf16x8 af[2], bfr[4];
#pragma unroll
                for (int m = 0; m < 2; ++m) af[m] = *(const bf16x8*)(VnT + (cb + 16 * m + lr) * 136 + ks * 32 + 8 * lq);
#pragma unroll
                for (int n = 0; n < 4; ++n) bfr[n] = *(const bf16x8*)(WsL + (ib + 16 * n + lr) * 136 + ks * 32 + 8 * lq);
#pragma unroll
                for (int m = 0; m < 2; ++m)
#pragma unroll
                    for (int n = 0; n < 4; ++n) acc[m][n] = __builtin_amdgcn_mfma_f32_16x16x32_bf16(af[m], bfr[n], acc[m][n], 0, 0, 0); }
#pragma unroll
            for (int m = 0; m < 2; ++m)
#pragma unroll
                for (int n = 0; n < 4; ++n) { const int i = ib + 16 * n + lr; const float bs = a_bs[g * 128 + i]; const int ch = g * 128 + cb + 16 * m + lq * 4;
                    const size_t off = (size_t)(tok0 + i) * DM + ch;
                    const u32x2 uw = *(const u32x2*)(UG + off);
                    u32x2 o; o.x = pk2(bflo(uw.x) * (acc[m][n][0] + bs), bfhi(uw.x) * (acc[m][n][1] + bs)); o.y = pk2(bflo(uw.y) * (acc[m][n][2] + bs), bfhi(uw.y) * (acc[m][n][3] + bs));
                    *(u32x2*)(AA + off) = o; }
            __syncthreads();
        }
    }
}

__device__ __forceinline__ void conv_emit(const u32x4 pv, const u32x4 cv, const u32x4 nv, const float* wp, int typ, bf16_t* dst) {
    const unsigned pu[4] = {pv.x, pv.y, pv.z, pv.w}, cu[4] = {cv.x, cv.y, cv.z, cv.w}, nu[4] = {nv.x, nv.y, nv.z, nv.w};
    float y[8]; float ss = 0.f;
#pragma unroll
    for (int e = 0; e < 4; ++e) {
        const float w00 = wp[2 * e], w01 = wp[2 * e + 1], w10 = wp[3072 + 2 * e], w11 = wp[3072 + 2 * e + 1], w20 = wp[6144 + 2 * e], w21 = wp[6144 + 2 * e + 1];
        const float a0 = w00 * bflo(pu[e]) + w10 * bflo(cu[e]) + w20 * bflo(nu[e]), a1 = w01 * bfhi(pu[e]) + w11 * bfhi(cu[e]) + w21 * bfhi(nu[e]);
        y[2 * e] = siluf_(a0); y[2 * e + 1] = siluf_(a1); ss += y[2 * e] * y[2 * e] + y[2 * e + 1] * y[2 * e + 1]; }
    if (typ != 1) { ss += __shfl_xor(ss, 1); ss += __shfl_xor(ss, 2); ss += __shfl_xor(ss, 4); ss += __shfl_xor(ss, 8);
        const float sc = (1.0f / sqrtf(ss + EPS)) * (typ == 2 ? 0.08838834764831845f : 1.0f);
#pragma unroll
        for (int e = 0; e < 8; ++e) y[e] *= sc; }
    u32x4 o; o.x = pk2(y[0], y[1]); o.y = pk2(y[2], y[3]); o.z = pk2(y[4], y[5]); o.w = pk2(y[6], y[7]);
    *(u32x4*)dst = o;
}
__device__ __forceinline__ void phase_conv_prep(const Args& a, const bf16_t* KV, const bf16_t* QR, const float* BA, bf16_t* KNx, bf16_t* VNx, bf16_t* KNc, bf16_t* VNc, bf16_t* QN, float* BETA, float* GG, int gw, int NGW, int lane) {
    const float* cw = a.in[8];
    const u32x4 z4 = (u32x4){0u, 0u, 0u, 0u};
    for (int it = gw; it < 2048; it += NGW) {
        const int blk = it >> 1, ch0 = (it & 1) * 512 + lane * 8, r0 = blk * 17;
        u32x4 W[3][3];
        auto row_ptr = [&](int typ, int r) -> const bf16_t* { return typ < 2 ? KV + (size_t)r * 2048 + typ * 1024 + ch0 : QR + (size_t)(r < NTOK ? r : 0) * 1024 + ch0; };
        auto seq_t = [&](int r) -> int { return r < NTOK ? (r & (SEQL - 1)) : ((r - NTOK) & (CTXL - 1)); };
        auto seq_L = [&](int r) -> int { return r < NTOK ? SEQL : CTXL; };
        {   const int t = seq_t(r0);
#pragma unroll
            for (int typ = 0; typ < 3; ++typ) { W[typ][0] = t > 0 ? *(const u32x4*)row_ptr(typ, r0 - 1) : z4; W[typ][1] = *(const u32x4*)row_ptr(typ, r0); }
        }
#pragma unroll 1
        for (int rr = 0; rr < 17; ++rr) { const int r = r0 + rr; const bool isx = r < NTOK; const int t = seq_t(r); const bool hasn = t < seq_L(r) - 1;
            const bool hasp = t > 0;
#pragma unroll
            for (int typ = 0; typ < 3; ++typ) W[typ][2] = (r + 1 < MROWS) ? *(const u32x4*)row_ptr(typ, r + 1) : z4;
#pragma unroll
            for (int typ = 0; typ < 3; ++typ) {
                if (typ == 2 && !isx) break;
                bf16_t* dst = typ == 0 ? (isx ? KNx + (size_t)r * DM : KNc + (size_t)(r - NTOK) * DM) : (typ == 1 ? (isx ? VNx + (size_t)r * DM : VNc + (size_t)(r - NTOK) * DM) : QN + (size_t)r * DM);
                conv_emit(hasp ? W[typ][0] : z4, W[typ][1], hasn ? W[typ][2] : z4, cw + typ * 1024 + ch0, typ, dst + ch0);
            }
            if ((it & 1) == 0 && lane < 16) { const int dir = lane >> 3, h = lane & 7;
                const float bl = BA[(size_t)r * 32 + dir * 8 + h], al = BA[(size_t)r * 32 + 16 + dir * 8 + h] + a.in[10][dir * 8 + h];
                const float sp = fmaxf(al, 0.f) + log1pf(__expf(-fabsf(al)));
                BETA[((size_t)dir * MROWS + r) * 8 + h] = sigmoidf_(bl);
                GG[((size_t)dir * MROWS + r) * 8 + h] = -__expf(a.in[9][dir * 8 + h]) * sp; }
#pragma unroll
            for (int typ = 0; typ < 3; ++typ) { W[typ][0] = W[typ][1]; W[typ][1] = W[typ][2]; }
        }
    }
}

__device__ __forceinline__ float row_allsum16(float x) {
    x += __int_as_float(__builtin_amdgcn_update_dpp(0, __float_as_int(x), 0x128, 0xf, 0xf, false));
    x += __int_as_float(__builtin_amdgcn_update_dpp(0, __float_as_int(x), 0x124, 0xf, 0xf, false));
    x += __int_as_float(__builtin_amdgcn_update_dpp(0, __float_as_int(x), 0x122, 0xf, 0xf, false));
    x += __int_as_float(__builtin_amdgcn_update_dpp(0, __float_as_int(x), 0x121, 0xf, 0xf, false));
    return x;
}
struct ScanBlk { u32x4 k[8], q[8]; bf16_t v[8]; float be[8], g[8]; };
__device__ __forceinline__ void scan_load(ScanBlk& B, const bf16_t* Kb, const bf16_t* Vb, const bf16_t* Qb, const float* BE, const float* GP, int s0, int n, int dir, int seg, int kk, int dvc, int h) {
#pragma unroll
    for (int j = 0; j < 8; ++j) { int s = s0 + j; s = s < n ? s : n - 1; const int t = dir ? n - 1 - s : s;
        B.k[j] = *(const u32x4*)(Kb + (size_t)t * DM + kk * 8);
        B.q[j] = seg ? *(const u32x4*)(Qb + (size_t)t * DM + kk * 8) : (u32x4){0u, 0u, 0u, 0u};
        B.v[j] = Vb[(size_t)t * DM + dvc];
        B.be[j] = BE[(size_t)t * 8 + h]; B.g[j] = GP[(size_t)t * 8 + h]; }
}
__device__ __forceinline__ void scan_compute(const ScanBlk& B, float (&S)[8], bf16_t* Ob, int s0, int n, int dir, int seg, int kk, int dvc) {
#pragma unroll
    for (int j = 0; j < 8; ++j) { const int s = s0 + j; const int t = dir ? n - 1 - s : s;
        const float e = __expf(B.g[j]);
        const float kf[8] = {bflo(B.k[j].x), bfhi(B.k[j].x), bflo(B.k[j].y), bfhi(B.k[j].y), bflo(B.k[j].z), bfhi(B.k[j].z), bflo(B.k[j].w), bfhi(B.k[j].w)};
        float p0 = kf[0] * S[0], p1 = kf[1] * S[1];
#pragma unroll
        for (int i = 2; i < 8; i += 2) { p0 += kf[i] * S[i]; p1 += kf[i + 1] * S[i + 1]; }
        const float part = row_allsum16(p0 + p1);
        const float delta = B.be[j] * (bf1(B.v[j]) - e * part);
#pragma unroll
        for (int i = 0; i < 8; ++i) S[i] = e * S[i] + kf[i] * delta;
        if (seg) {
            const float qf[8] = {bflo(B.q[j].x), bfhi(B.q[j].x), bflo(B.q[j].y), bfhi(B.q[j].y), bflo(B.q[j].z), bfhi(B.q[j].z), bflo(B.q[j].w), bfhi(B.q[j].w)};
            float q0 = qf[0] * S[0], q1 = qf[1] * S[1];
#pragma unroll
            for (int i = 2; i < 8; i += 2) { q0 += qf[i] * S[i]; q1 += qf[i + 1] * S[i + 1]; }
            const float po = row_allsum16(q0 + q1);
            if (kk == 0) Ob[(size_t)t * DM + dvc] = (bf16_t)f2bf(po);
        }
    }
}
__device__ __forceinline__ void phase_scan(const bf16_t* KNx, const bf16_t* VNx, const bf16_t* KNc, const bf16_t* VNc, const bf16_t* QN, const float* BETA, const float* GG, bf16_t* OF, bf16_t* OB, int gw, int NGW, int lane) {
    for (int it = gw; it < 2048; it += NGW) {
        const int sl = it & 31, h = (it >> 5) & 7, b = (it >> 8) & 3, dir = it >> 10;
        const int kk = lane & 15, c = lane >> 4, dvc = sl * 4 + c;
        float S[8];
#pragma unroll
        for (int i = 0; i < 8; ++i) S[i] = 0.f;
        bf16_t* Ob = (dir ? OB : OF) + (size_t)b * SEQL * DM + h * 128;
        for (int seg = 0; seg < 2; ++seg) {
            const int n = seg ? SEQL : CTXL;
            const bf16_t* Kb = (seg ? KNx + (size_t)b * SEQL * DM : KNc + (size_t)b * CTXL * DM) + h * 128;
            const bf16_t* Vb = (seg ? VNx + (size_t)b * SEQL * DM : VNc + (size_t)b * CTXL * DM) + h * 128;
            const bf16_t* Qb = QN + (size_t)b * SEQL * DM + h * 128;
            const size_t rb = (size_t)dir * MROWS + (seg ? b * SEQL : NTOK + b * CTXL);
            const float* BE = BETA + rb * 8; const float* GP = GG + rb * 8;
            ScanBlk A, B;
            scan_load(A, Kb, Vb, Qb, BE, GP, 0, n, dir, seg, kk, dvc, h);
            for (int s0 = 0; s0 < n; s0 += 16) {
                scan_load(B, Kb, Vb, Qb, BE, GP, s0 + 8, n, dir, seg, kk, dvc, h);
                scan_compute(A, S, Ob, s0, n, dir, seg, kk, dvc);
                scan_load(A, Kb, Vb, Qb, BE, GP, s0 + 16, n, dir, seg, kk, dvc, h);
                scan_compute(B, S, Ob, s0 + 8, n, dir, seg, kk, dvc);
            }
        }
    }
}

typedef float f32x16 __attribute__((ext_vector_type(16)));
#define MFMA32(a, b, c) __builtin_amdgcn_mfma_f32_32x32x16_bf16((a), (b), (c), 0, 0, 0)
__device__ __forceinline__ int crow(int reg, int h) { return (reg & 3) + 8 * (reg >> 2) + 4 * h; }
__device__ __forceinline__ bf16x8 pack8(const f32x16& x, int s) {
    u32x4 p; p.x = cvt2(x[8 * s], x[8 * s + 1]); p.y = cvt2(x[8 * s + 2], x[8 * s + 3]); p.z = cvt2(x[8 * s + 4], x[8 * s + 5]); p.w = cvt2(x[8 * s + 6], x[8 * s + 7]);
    return __builtin_bit_cast(bf16x8, p);
}
__device__ __forceinline__ f32x16 zero16() { f32x16 z;
#pragma unroll
    for (int i = 0; i < 16; ++i) z[i] = 0.f;
    return z; }
constexpr int NCH = 68;
constexpr int PREP_LDS = 64 * 68 * 4 + 512;

__device__ __forceinline__ void phase_chunk_prep(unsigned char* shm, const bf16_t* KNx, const bf16_t* KNc, const bf16_t* QN, const float* BETA, const float* GG, bf16_t* TT, bf16_t* QG, float* GC, int gw, int NGW, int wave, int lane) {
    float* Am = (float*)(shm + wave * PREP_LDS);
    float* gcl = Am + 64 * 68; float* bl = gcl + 64;
    for (int qi = gw; qi < 64 * NCH; qi += NGW) {
        const int it = qi < 256 ? (qi >> 2) * NCH + (qi & 3) : ((qi - 256) >> 6) * NCH + 4 + ((qi - 256) & 63);
        int r = lane & 31, hh = lane >> 5; asm volatile("" : "+v"(r), "+v"(hh));
        const int cidx = it % NCH, sc = it / NCH, h = sc & 7, b = (sc >> 3) & 3, dir = sc >> 5;
        const bool isx = cidx >= 4; const int cl = isx ? cidx - 4 : cidx, Ls = isx ? SEQL : CTXL;
        const int t0 = dir ? Ls - 1 - cl * 64 : cl * 64, ts = dir ? -1 : 1;
        const bf16_t* Kp = (isx ? KNx + (size_t)b * SEQL * DM : KNc + (size_t)b * CTXL * DM) + h * 128;
        const bf16_t* Qp = QN + (size_t)b * SEQL * DM + h * 128;
        const size_t rowbase = (size_t)dir * MROWS + (isx ? b * SEQL : NTOK + b * CTXL);
        { const int t = t0 + ts * lane; float g = GG[(rowbase + t) * 8 + h]; const float be = BETA[(rowbase + t) * 8 + h];
#pragma unroll
          for (int o = 1; o < 64; o <<= 1) { const float v = __shfl_up(g, o); if (lane >= o) g += v; }
          gcl[lane] = g; bl[lane] = be; GC[(size_t)it * 64 + lane] = g; }
        LDS_WAIT();
        bf16x8 kf[2][8];
#pragma unroll
        for (int ti = 0; ti < 2; ++ti)
#pragma unroll
            for (int s = 0; s < 8; ++s) kf[ti][s] = *(const bf16x8*)(Kp + (size_t)(t0 + ts * (32 * ti + r)) * DM + 16 * s + 8 * hh);
        f32x16 d00 = zero16(), d10 = zero16(), d11 = zero16();
#pragma unroll
        for (int s = 0; s < 8; ++s) { d00 = MFMA32(kf[0][s], kf[0][s], d00); d10 = MFMA32(kf[1][s], kf[0][s], d10); d11 = MFMA32(kf[1][s], kf[1][s], d11); }
        __builtin_amdgcn_sched_barrier(0);
        const float gcj0 = gcl[r], gcj1 = gcl[32 + r];
#pragma unroll
        for (int rho = 0; rho < 16; ++rho) { const int i0 = crow(rho, hh), i1 = 32 + i0;
            { const float gi = gcl[i0], bi = bl[i0]; Am[i0 * 68 + r] = (i0 > r) ? bi * d00[rho] * __expf(fminf(gi - gcj0, 0.f)) : 0.f; }
            { const float gi = gcl[i1], bi = bl[i1]; Am[i1 * 68 + r] = bi * d10[rho] * __expf(fminf(gi - gcj0, 0.f));
              Am[i1 * 68 + 32 + r] = (i1 > 32 + r) ? bi * d11[rho] * __expf(fminf(gi - gcj1, 0.f)) : 0.f; } }
        LDS_WAIT();
        __builtin_amdgcn_sched_barrier(0);
        if (isx) {
            bf16x8 qf[2][8];
#pragma unroll
            for (int ti = 0; ti < 2; ++ti)
#pragma unroll
                for (int s = 0; s < 8; ++s) qf[ti][s] = *(const bf16x8*)(Qp + (size_t)(t0 + ts * (32 * ti + r)) * DM + 16 * s + 8 * hh);
            f32x16 e00 = zero16(), e10 = zero16(), e11 = zero16();
#pragma unroll
            for (int s = 0; s < 8; ++s) { e00 = MFMA32(qf[0][s], kf[0][s], e00); e10 = MFMA32(qf[1][s], kf[0][s], e10); e11 = MFMA32(qf[1][s], kf[1][s], e11); }
            bf16_t* Qout = QG + (size_t)it * 4096;
#pragma unroll
            for (int rho = 0; rho < 16; ++rho) { const int i0 = crow(rho, hh), i1 = 32 + i0;
                { const float gi = gcl[i0]; Qout[i0 * 64 + r] = (i0 >= r) ? (bf16_t)f2bf(e00[rho] * __expf(fminf(gi - gcj0, 0.f))) : (bf16_t)0; Qout[i0 * 64 + 32 + r] = (bf16_t)0; }
                { const float gi = gcl[i1]; Qout[i1 * 64 + r] = (bf16_t)f2bf(e10[rho] * __expf(fminf(gi - gcj0, 0.f)));
                  Qout[i1 * 64 + 32 + r] = (i1 >= 32 + r) ? (bf16_t)f2bf(e11[rho] * __expf(fminf(gi - gcj1, 0.f))) : (bf16_t)0; } }
        }
        __builtin_amdgcn_sched_barrier(0);
        {
            float Tc[64]; bf16_t* Tout = TT + (size_t)it * 4096;
#pragma unroll
            for (int i = 0; i < 64; ++i) { float p0 = (lane == i) ? 1.f : 0.f, p1 = 0.f, p2 = 0.f, p3 = 0.f;
#pragma unroll
                for (int j = 0; j < i; ++j) { const float av = Am[i * 68 + j];
                    if ((j & 3) == 0) p0 -= av * Tc[j]; else if ((j & 3) == 1) p1 -= av * Tc[j]; else if ((j & 3) == 2) p2 -= av * Tc[j]; else p3 -= av * Tc[j]; }
                Tc[i] = (p0 + p1) + (p2 + p3);
                Tout[i * 64 + lane] = (bf16_t)f2bf(Tc[i]); }
        }
        LDS_WAIT();
    }
}

constexpr int SC_K = 0, SC_Q = 64 * 136 * 2, SC_KT = SC_Q + 64 * 136 * 2, SC_T = SC_KT + 128 * 72 * 2, SC_QG = SC_T + 64 * 72 * 2, SC_V = SC_QG + 64 * 72 * 2, SC_BE = SC_V + 64 * 32 * 2, SC_EG = SC_BE + 256, SC_ED = SC_EG + 256, SC_STAGE = SC_ED + 512;
static_assert(2 * SC_STAGE <= 159744 - 16, "scan LDS");
__device__ __forceinline__ int perm16(int x) { return (x & ~12) | ((x & 4) << 1) | ((x & 8) >> 1); }

struct ScanRegs { u32x4 buf[8]; float gc, gce, be; };
struct ScanItem { const bf16_t *Kp, *Vp, *Qp, *Tp, *Gp; const float *GCp, *BEp; int t0, ts; bool isx; };
__device__ __forceinline__ ScanItem scan_item(int cidx, int dir, int b, int h, int sl, const bf16_t* KNx, const bf16_t* VNx, const bf16_t* KNc, const bf16_t* VNc, const bf16_t* QN, const float* BETA, const float* GC, const bf16_t* TT, const bf16_t* QG) {
    ScanItem I; I.isx = cidx >= 4; const int cl = I.isx ? cidx - 4 : cidx, Ls = I.isx ? SEQL : CTXL;
    I.t0 = dir ? Ls - 1 - cl * 64 : cl * 64; I.ts = dir ? -1 : 1;
    I.Kp = (I.isx ? KNx + (size_t)b * SEQL * DM : KNc + (size_t)b * CTXL * DM) + h * 128;
    I.Vp = (I.isx ? VNx + (size_t)b * SEQL * DM : VNc + (size_t)b * CTXL * DM) + h * 128 + sl * 32;
    I.Qp = QN + (size_t)b * SEQL * DM + h * 128;
    const size_t item = (size_t)((dir * 4 + b) * 8 + h) * NCH + cidx;
    I.Tp = TT + item * 4096; I.Gp = QG + item * 4096; I.GCp = GC + item * 64;
    I.BEp = BETA + ((size_t)dir * MROWS + (I.isx ? b * SEQL : NTOK + b * CTXL)) * 8 + h;
    return I;
}
__device__ __forceinline__ void scan_load(ScanRegs& R, const ScanItem& I, int tp) {
    asm volatile("" : "+v"(tp));
    if (tp < 64) { R.gc = I.GCp[tp]; R.gce = I.GCp[63]; R.be = I.BEp[(size_t)(I.t0 + I.ts * tp) * 8]; }
#pragma unroll
    for (int m = 0; m < 8; ++m) { const int p = tp + 448 * m; R.buf[m] = (u32x4){0u, 0u, 0u, 0u};
        if (p < 1024) { const int i = p & 63, p8 = p >> 6; R.buf[m] = *(const u32x4*)(I.Kp + (size_t)(I.t0 + I.ts * i) * DM + 8 * p8); }
        else if (p < 2048) { if (I.isx) { const int q = p - 1024, i = q >> 4, p8 = q & 15; R.buf[m] = *(const u32x4*)(I.Qp + (size_t)(I.t0 + I.ts * i) * DM + 8 * p8); } }
        else if (p < 2560) { const int q = p - 2048; R.buf[m] = *(const u32x4*)(I.Tp + 8 * q); }
        else if (p < 3072) { if (I.isx) { const int q = p - 2560; R.buf[m] = *(const u32x4*)(I.Gp + 8 * q); } }
        else if (p < 3328) { const int q = p - 3072, i = q >> 2, c8 = q & 3; R.buf[m] = *(const u32x4*)(I.Vp + (size_t)(I.t0 + I.ts * i) * DM + 8 * c8); } }
}
__device__ __forceinline__ void scan_write(const ScanRegs& R, bool isx, unsigned char* st, int tp) {
    asm volatile("" : "+v"(tp));
    bf16_t* kL = (bf16_t*)(st + SC_K); bf16_t* qL = (bf16_t*)(st + SC_Q); bf16_t* kTL = (bf16_t*)(st + SC_KT); bf16_t* TL = (bf16_t*)(st + SC_T); bf16_t* QL = (bf16_t*)(st + SC_QG); bf16_t* vL = (bf16_t*)(st + SC_V);
    if (tp < 64) { ((float*)(st + SC_BE))[tp] = R.be; ((float*)(st + SC_EG))[tp] = __expf(R.gc); ((float*)(st + SC_ED))[tp] = __expf(R.gce - R.gc); }
#pragma unroll
    for (int m = 0; m < 8; ++m) { const int p = tp + 448 * m; const u32x2 lo = (u32x2){R.buf[m].x, R.buf[m].y}, hi = (u32x2){R.buf[m].z, R.buf[m].w};
        const unsigned w4[4] = {R.buf[m].x, R.buf[m].y, R.buf[m].z, R.buf[m].w};
        if (p < 1024) { const int i = p & 63, p8 = p >> 6, s = p8 >> 1, a = p8 & 1;
            *(u32x2*)(kL + i * 136 + 16 * s + 4 * a) = lo; *(u32x2*)(kL + i * 136 + 16 * s + 8 + 4 * a) = hi;
            const int pi = perm16(i);
#pragma unroll
            for (int e = 0; e < 4; ++e) { kTL[(8 * p8 + 2 * e) * 72 + pi] = (bf16_t)(w4[e] & 0xffffu); kTL[(8 * p8 + 2 * e + 1) * 72 + pi] = (bf16_t)(w4[e] >> 16); } }
        else if (p < 2048) { if (isx) { const int q = p - 1024, i = q >> 4, p8 = q & 15, s = p8 >> 1, a = p8 & 1;
            *(u32x2*)(qL + i * 136 + 16 * s + 4 * a) = lo; *(u32x2*)(qL + i * 136 + 16 * s + 8 + 4 * a) = hi; } }
        else if (p < 2560) { const int q = p - 2048, i = q >> 3, p8 = q & 7, s = p8 >> 1, a = p8 & 1;
            *(u32x2*)(TL + i * 72 + 16 * s + 4 * a) = lo; *(u32x2*)(TL + i * 72 + 16 * s + 8 + 4 * a) = hi; }
        else if (p < 3072) { if (isx) { const int q = p - 2560, i = q >> 3, p8 = q & 7, s = p8 >> 1, a = p8 & 1;
            *(u32x2*)(QL + i * 72 + 16 * s + 4 * a) = lo; *(u32x2*)(QL + i * 72 + 16 * s + 8 + 4 * a) = hi; } }
        else if (p < 3328) { const int q = p - 3072, i = q >> 2, c8 = q & 3;
#pragma unroll
            for (int e = 0; e < 4; ++e) { vL[((i >> 2) * 32 + 8 * c8 + 2 * e) * 4 + (i & 3)] = (bf16_t)(w4[e] & 0xffffu); vL[((i >> 2) * 32 + 8 * c8 + 2 * e + 1) * 4 + (i & 3)] = (bf16_t)(w4[e] >> 16); } } }
}

__device__ __forceinline__ void scan_consume(const unsigned char* st, f32x16 (&S)[4], bf16x8 (&Sb)[4][2], bool isx, bf16_t* Olow, int dir, int lane) {
    int r = lane & 31, hh = lane >> 5; asm volatile("" : "+v"(r), "+v"(hh));
    const bf16_t* kL = (const bf16_t*)(st + SC_K); const bf16_t* qL = (const bf16_t*)(st + SC_Q); const bf16_t* kTL = (const bf16_t*)(st + SC_KT); const bf16_t* TL = (const bf16_t*)(st + SC_T);
    const bf16_t* QL = (const bf16_t*)(st + SC_QG); const bf16_t* vL = (const bf16_t*)(st + SC_V);
    const float* BE = (const float*)(st + SC_BE); const float* EG = (const float*)(st + SC_EG); const float* ED = (const float*)(st + SC_ED);
    bf16x8 kA[2][4];
#pragma unroll
    for (int s = 0; s < 4; ++s)
#pragma unroll
        for (int tl = 0; tl < 2; ++tl) kA[tl][s] = *(const bf16x8*)(kL + (32 * tl + r) * 136 + 16 * s + 8 * hh);
    f32x16 X[2]; X[0] = zero16(); X[1] = zero16();
#pragma unroll
    for (int s = 0; s < 8; ++s) {
#pragma unroll
        for (int tl = 0; tl < 2; ++tl) X[tl] = MFMA32(kA[tl][s & 3], Sb[s >> 1][s & 1], X[tl]);
        if (s < 4) {
#pragma unroll
            for (int tl = 0; tl < 2; ++tl) kA[tl][s & 3] = *(const bf16x8*)(kL + (32 * tl + r) * 136 + 16 * (s + 4) + 8 * hh); }
    }
    bf16x8 tA[6];
#pragma unroll
    for (int s2 = 0; s2 < 2; ++s2) { tA[3 * s2] = *(const bf16x8*)(TL + r * 72 + 16 * s2 + 8 * hh); tA[3 * s2 + 1] = *(const bf16x8*)(TL + (32 + r) * 72 + 16 * s2 + 8 * hh); tA[3 * s2 + 2] = *(const bf16x8*)(TL + (32 + r) * 72 + 32 + 16 * s2 + 8 * hh); }
    const float ee = EG[63];
#pragma unroll
    for (int tl = 0; tl < 2; ++tl)
#pragma unroll
        for (int g = 0; g < 4; ++g) { const int i0 = 32 * tl + 8 * g + 4 * hh; const f32x4 be = *(const f32x4*)(BE + i0), eg = *(const f32x4*)(EG + i0); const u32x2 vw = *(const u32x2*)(vL + ((i0 >> 2) * 32 + r) * 4);
            X[tl][4 * g + 0] = be[0] * (bflo(vw.x) - eg[0] * X[tl][4 * g + 0]); X[tl][4 * g + 1] = be[1] * (bfhi(vw.x) - eg[1] * X[tl][4 * g + 1]);
            X[tl][4 * g + 2] = be[2] * (bflo(vw.y) - eg[2] * X[tl][4 * g + 2]); X[tl][4 * g + 3] = be[3] * (bfhi(vw.y) - eg[3] * X[tl][4 * g + 3]); }
    bf16x8 Xb[2][2];
#pragma unroll
    for (int tl = 0; tl < 2; ++tl)
#pragma unroll
        for (int s2 = 0; s2 < 2; ++s2) Xb[tl][s2] = pack8(X[tl], s2);
    f32x16 Vn[2]; Vn[0] = zero16(); Vn[1] = zero16();
#pragma unroll
    for (int s2 = 0; s2 < 2; ++s2) { Vn[0] = MFMA32(tA[3 * s2], Xb[0][s2], Vn[0]); Vn[1] = MFMA32(tA[3 * s2 + 1], Xb[0][s2], Vn[1]); Vn[1] = MFMA32(tA[3 * s2 + 2], Xb[1][s2], Vn[1]); }
    bf16x8 ktA[2][4], qA[4];
#pragma unroll
    for (int tj = 0; tj < 2; ++tj)
#pragma unroll
        for (int s2 = 0; s2 < 2; ++s2) ktA[0][2 * tj + s2] = *(const bf16x8*)(kTL + r * 72 + 32 * tj + 16 * s2 + 8 * hh);
#pragma unroll
    for (int kt = 0; kt < 4; ++kt) {
#pragma unroll
        for (int rho = 0; rho < 16; ++rho) S[kt][rho] *= ee; }
    bf16x8 Vb[2][2], Vd[2][2];
#pragma unroll
    for (int tl = 0; tl < 2; ++tl) { f32x16 t;
#pragma unroll
        for (int g = 0; g < 4; ++g) { const f32x4 ed = *(const f32x4*)(ED + 32 * tl + 8 * g + 4 * hh);
#pragma unroll
            for (int e = 0; e < 4; ++e) t[4 * g + e] = Vn[tl][4 * g + e] * ed[e]; }
#pragma unroll
        for (int s2 = 0; s2 < 2; ++s2) { Vb[tl][s2] = pack8(Vn[tl], s2); Vd[tl][s2] = pack8(t, s2); } }
    f32x16 O[2]; O[0] = zero16(); O[1] = zero16();
#pragma unroll
    for (int kt = 0; kt < 4; ++kt) {
        if (isx) {
#pragma unroll
            for (int s2 = 0; s2 < 2; ++s2)
#pragma unroll
                for (int tl = 0; tl < 2; ++tl) qA[2 * s2 + tl] = *(const bf16x8*)(qL + (32 * tl + r) * 136 + 32 * kt + 16 * s2 + 8 * hh);
        }
        if (kt < 3) {
#pragma unroll
            for (int tj = 0; tj < 2; ++tj)
#pragma unroll
                for (int s2 = 0; s2 < 2; ++s2) ktA[(kt + 1) & 1][2 * tj + s2] = *(const bf16x8*)(kTL + (32 * (kt + 1) + r) * 72 + 32 * tj + 16 * s2 + 8 * hh);
        }
#pragma unroll
        for (int tj = 0; tj < 2; ++tj)
#pragma unroll
            for (int s2 = 0; s2 < 2; ++s2) S[kt] = MFMA32(ktA[kt & 1][2 * tj + s2], Vd[tj][s2], S[kt]);
        if (isx) {
#pragma unroll
            for (int s2 = 0; s2 < 2; ++s2)
#pragma unroll
                for (int tl = 0; tl < 2; ++tl) O[tl] = MFMA32(qA[2 * s2 + tl], Sb[kt][s2], O[tl]);
        }
#pragma unroll
        for (int s2 = 0; s2 < 2; ++s2) Sb[kt][s2] = pack8(S[kt], s2); }
    if (isx) {
#pragma unroll
        for (int tl = 0; tl < 2; ++tl)
#pragma unroll
            for (int g = 0; g < 4; ++g) { const f32x4 eg = *(const f32x4*)(EG + 32 * tl + 8 * g + 4 * hh);
#pragma unroll
                for (int e = 0; e < 4; ++e) O[tl][4 * g + e] *= eg[e]; }
#pragma unroll
        for (int s2 = 0; s2 < 2; ++s2) {
            O[0] = MFMA32(*(const bf16x8*)(QL + r * 72 + 16 * s2 + 8 * hh), Vb[0][s2], O[0]);
            O[1] = MFMA32(*(const bf16x8*)(QL + (32 + r) * 72 + 16 * s2 + 8 * hh), Vb[0][s2], O[1]);
            O[1] = MFMA32(*(const bf16x8*)(QL + (32 + r) * 72 + 32 + 16 * s2 + 8 * hh), Vb[1][s2], O[1]); }
        const int osgn = dir ? -1 : 1; const int lane_off = ((dir ? 63 - 4 * hh : 4 * hh) * DM + r) * 2;
#pragma unroll
        for (int tl = 0; tl < 2; ++tl)
#pragma unroll
            for (int rho = 0; rho < 16; rho += 2) { const int c0 = 32 * tl + (rho & 3) + 8 * (rho >> 2); const unsigned w = cvt2(O[tl][rho], O[tl][rho + 1]);
                *(bf16_t*)((char*)Olow + (unsigned)(lane_off + osgn * c0 * (DM * 2))) = (bf16_t)(w & 0xffffu);
                *(bf16_t*)((char*)Olow + (unsigned)(lane_off + osgn * (c0 + 1) * (DM * 2))) = (bf16_t)(w >> 16); }
    }
}

#define MFMA16(a, b, c) __builtin_amdgcn_mfma_f32_16x16x32_bf16((a), (b), (c), 0, 0, 0)
__device__ __forceinline__ int perm32(int x) { return (x & 32) | ((x & 12) << 1) | ((x & 16) >> 2) | (x & 3); }
__device__ __forceinline__ bf16x8 pack44(const f32x4& t0, const f32x4& t1) { u32x4 p; p.x = cvt2(t0[0], t0[1]); p.y = cvt2(t0[2], t0[3]); p.z = cvt2(t1[0], t1[1]); p.w = cvt2(t1[2], t1[3]); return __builtin_bit_cast(bf16x8, p); }
struct ScanRegs16 { u32x4 buf[9]; float gc, gce, be; };
__device__ __forceinline__ void scan_load16(ScanRegs16& R, const ScanItem& I, int tp) {
    asm volatile("" : "+v"(tp));
    if (tp < 64) { R.gc = I.GCp[tp]; R.gce = I.GCp[63]; R.be = I.BEp[(size_t)(I.t0 + I.ts * tp) * 8]; }
#pragma unroll
    for (int m = 0; m < 9; ++m) { const int p = tp + 384 * m; R.buf[m] = (u32x4){0u, 0u, 0u, 0u};
        if (p < 1024) { const int i = p & 63, p8 = p >> 6; R.buf[m] = *(const u32x4*)(I.Kp + (size_t)(I.t0 + I.ts * i) * DM + 8 * p8); }
        else if (p < 2048) { if (I.isx) { const int q = p - 1024, i = q >> 4, p8 = q & 15; R.buf[m] = *(const u32x4*)(I.Qp + (size_t)(I.t0 + I.ts * i) * DM + 8 * p8); } }
        else if (p < 2560) { const int q = p - 2048; R.buf[m] = *(const u32x4*)(I.Tp + 8 * q); }
        else if (p < 3072) { if (I.isx) { const int q = p - 2560; R.buf[m] = *(const u32x4*)(I.Gp + 8 * q); } }
        else if (p < 3328) { const int q = p - 3072, i = q >> 2, c8 = q & 3; R.buf[m] = *(const u32x4*)(I.Vp + (size_t)(I.t0 + I.ts * i) * DM + 8 * c8); } }
}
__device__ __forceinline__ int pos16lo(int p8) { return 32 * (p8 >> 2) + 16 * (p8 & 1) + 4 * ((p8 >> 1) & 1); }
__device__ __forceinline__ void scan_write16(const ScanRegs16& R, bool isx, unsigned char* st, int tp) {
    asm volatile("" : "+v"(tp));
    bf16_t* kL = (bf16_t*)(st + SC_K); bf16_t* qL = (bf16_t*)(st + SC_Q); bf16_t* kTL = (bf16_t*)(st + SC_KT); bf16_t* TL = (bf16_t*)(st + SC_T); bf16_t* QL = (bf16_t*)(st + SC_QG); bf16_t* vL = (bf16_t*)(st + SC_V);
    if (tp < 64) { ((float*)(st + SC_BE))[tp] = R.be; ((float*)(st + SC_EG))[tp] = __expf(R.gc); ((float*)(st + SC_ED))[tp] = __expf(R.gce - R.gc); }
#pragma unroll
    for (int m = 0; m < 9; ++m) { const int p = tp + 384 * m; const u32x2 lo = (u32x2){R.buf[m].x, R.buf[m].y}, hi = (u32x2){R.buf[m].z, R.buf[m].w};
        const unsigned w4[4] = {R.buf[m].x, R.buf[m].y, R.buf[m].z, R.buf[m].w};
        if (p < 1024) { const int i = p & 63, p8 = p >> 6, c0 = pos16lo(p8);
            *(u32x2*)(kL + i * 136 + c0) = lo; *(u32x2*)(kL + i * 136 + c0 + 8) = hi;
            const int pi = perm32(i);
#pragma unroll
            for (int e = 0; e < 4; ++e) { kTL[(8 * p8 + 2 * e) * 72 + pi] = (bf16_t)(w4[e] & 0xffffu); kTL[(8 * p8 + 2 * e + 1) * 72 + pi] = (bf16_t)(w4[e] >> 16); } }
        else if (p < 2048) { if (isx) { const int q = p - 1024, i = q >> 4, p8 = q & 15, c0 = pos16lo(p8);
            *(u32x2*)(qL + i * 136 + c0) = lo; *(u32x2*)(qL + i * 136 + c0 + 8) = hi; } }
        else if (p < 2560) { const int q = p - 2048, i = q >> 3, p8 = q & 7, c0 = pos16lo(p8);
            *(u32x2*)(TL + i * 72 + c0) = lo; *(u32x2*)(TL + i * 72 + c0 + 8) = hi; }
        else if (p < 3072) { if (isx) { const int q = p - 2560, i = q >> 3, p8 = q & 7, c0 = pos16lo(p8);
            *(u32x2*)(QL + i * 72 + c0) = lo; *(u32x2*)(QL + i * 72 + c0 + 8) = hi; } }
        else if (p < 3328) { const int q = p - 3072, i = q >> 2, c8 = q & 3;
#pragma unroll
            for (int e = 0; e < 4; ++e) { vL[((i >> 2) * 32 + 8 * c8 + 2 * e) * 4 + (i & 3)] = (bf16_t)(w4[e] & 0xffffu); vL[((i >> 2) * 32 + 8 * c8 + 2 * e + 1) * 4 + (i & 3)] = (bf16_t)(w4[e] >> 16); } } }
}
__device__ __forceinline__ void scan_consume16(const unsigned char* st, f32x4 (&S)[8], bf16x8 (&Sb)[4], bool isx, bf16_t* Olow, int dir, int cw, int lane) {
    int r = lane & 15, q = lane >> 4; asm volatile("" : "+v"(r), "+v"(q));
    const bf16_t* kL = (const bf16_t*)(st + SC_K); const bf16_t* qL = (const bf16_t*)(st + SC_Q); const bf16_t* kTL = (const bf16_t*)(st + SC_KT); const bf16_t* TL = (const bf16_t*)(st + SC_T);
    const bf16_t* QL = (const bf16_t*)(st + SC_QG); const bf16_t* vL = (const bf16_t*)(st + SC_V);
    const float* BE = (const float*)(st + SC_BE); const float* EG = (const float*)(st + SC_EG); const float* ED = (const float*)(st + SC_ED);
    const f32x4 z4f = (f32x4){0.f, 0.f, 0.f, 0.f};
    bf16x8 kA[4][4], tA[6];
#pragma unroll
    for (int kb = 0; kb < 4; ++kb)
#pragma unroll
        for (int ti = 0; ti < 4; ++ti) kA[kb][ti] = *(const bf16x8*)(kL + (16 * ti + r) * 136 + 32 * kb + 8 * q);
#pragma unroll
    for (int ti = 0; ti < 4; ++ti) tA[ti] = *(const bf16x8*)(TL + (16 * ti + r) * 72 + 8 * q);
    tA[4] = *(const bf16x8*)(TL + (32 + r) * 72 + 32 + 8 * q); tA[5] = *(const bf16x8*)(TL + (48 + r) * 72 + 32 + 8 * q);
    f32x4 beF[4], egF[4], edF[4]; u32x2 vF[4];
#pragma unroll
    for (int ti = 0; ti < 4; ++ti) { const int i0 = 16 * ti + 4 * q; beF[ti] = *(const f32x4*)(BE + i0); egF[ti] = *(const f32x4*)(EG + i0); edF[ti] = *(const f32x4*)(ED + i0); vF[ti] = *(const u32x2*)(vL + ((i0 >> 2) * 32 + 16 * cw + r) * 4); }
    const float ee = EG[63];
    LDS_WAIT();
    __builtin_amdgcn_sched_barrier(0);
    f32x4 X[4]; X[0] = z4f; X[1] = z4f; X[2] = z4f; X[3] = z4f;
#pragma unroll
    for (int kb = 0; kb < 4; ++kb)
#pragma unroll
        for (int ti = 0; ti < 4; ++ti) X[ti] = MFMA16(kA[kb][ti], Sb[kb], X[ti]);
    __builtin_amdgcn_sched_barrier(0);
    bf16x8 ktA[8][2];
#pragma unroll
    for (int t = 0; t < 8; ++t)
#pragma unroll
        for (int kb = 0; kb < 2; ++kb) ktA[t][kb] = *(const bf16x8*)(kTL + (16 * t + r) * 72 + 32 * kb + 8 * q);
    __builtin_amdgcn_sched_barrier(0);
#pragma unroll
    for (int ti = 0; ti < 4; ++ti) { const f32x4 be = beF[ti], eg = egF[ti]; const u32x2 vw = vF[ti];
        X[ti][0] = be[0] * (bflo(vw.x) - eg[0] * X[ti][0]); X[ti][1] = be[1] * (bfhi(vw.x) - eg[1] * X[ti][1]); X[ti][2] = be[2] * (bflo(vw.y) - eg[2] * X[ti][2]); X[ti][3] = be[3] * (bfhi(vw.y) - eg[3] * X[ti][3]); }
    bf16x8 Xb[2]; Xb[0] = pack44(X[0], X[1]); Xb[1] = pack44(X[2], X[3]);
    f32x4 Vn[4];
#pragma unroll
    for (int ti = 0; ti < 4; ++ti) Vn[ti] = MFMA16(tA[ti], Xb[0], z4f);
    Vn[2] = MFMA16(tA[4], Xb[1], Vn[2]); Vn[3] = MFMA16(tA[5], Xb[1], Vn[3]);
    f32x4 Vs[4];
#pragma unroll
    for (int ti = 0; ti < 4; ++ti) Vs[ti] = Vn[ti] * edF[ti];
    bf16x8 Vb[2], Vd[2]; Vb[0] = pack44(Vn[0], Vn[1]); Vb[1] = pack44(Vn[2], Vn[3]); Vd[0] = pack44(Vs[0], Vs[1]); Vd[1] = pack44(Vs[2], Vs[3]);
    LDS_WAIT();
    __builtin_amdgcn_sched_barrier(0);
#pragma unroll
    for (int t = 0; t < 8; ++t) { S[t] = S[t] * ee;
#pragma unroll
        for (int kb = 0; kb < 2; ++kb) S[t] = MFMA16(ktA[t][kb], Vd[kb], S[t]); }
    __builtin_amdgcn_sched_barrier(0);
    f32x4 O[4]; O[0] = z4f; O[1] = z4f; O[2] = z4f; O[3] = z4f;
    if (isx) {
        bf16x8 qA[4][4], gA[6];
#pragma unroll
        for (int kb = 0; kb < 4; ++kb)
#pragma unroll
            for (int ti = 0; ti < 4; ++ti) qA[kb][ti] = *(const bf16x8*)(qL + (16 * ti + r) * 136 + 32 * kb + 8 * q);
#pragma unroll
        for (int ti = 0; ti < 4; ++ti) gA[ti] = *(const bf16x8*)(QL + (16 * ti + r) * 72 + 8 * q);
        gA[4] = *(const bf16x8*)(QL + (32 + r) * 72 + 32 + 8 * q); gA[5] = *(const bf16x8*)(QL + (48 + r) * 72 + 32 + 8 * q);
        LDS_WAIT();
        __builtin_amdgcn_sched_barrier(0);
#pragma unroll
        for (int kb = 0; kb < 4; ++kb)
#pragma unroll
            for (int ti = 0; ti < 4; ++ti) O[ti] = MFMA16(qA[kb][ti], Sb[kb], O[ti]);
#pragma unroll
        for (int ti = 0; ti < 4; ++ti) { O[ti] = O[ti] * egF[ti]; O[ti] = MFMA16(gA[ti], Vb[0], O[ti]); }
        O[2] = MFMA16(gA[4], Vb[1], O[2]); O[3] = MFMA16(gA[5], Vb[1], O[3]);
    }
#pragma unroll
    for (int kb = 0; kb < 4; ++kb) Sb[kb] = pack44(S[2 * kb], S[2 * kb + 1]);
    if (isx) {
        const int osgn = dir ? -1 : 1; const int lane_off = ((dir ? 63 - 4 * q : 4 * q) * DM + 16 * cw + r) * 2;
#pragma unroll
        for (int ti = 0; ti < 4; ++ti)
#pragma unroll
            for (int e = 0; e < 4; e += 2) { const int c0 = 16 * ti + e; const unsigned w = cvt2(O[ti][e], O[ti][e + 1]);
                *(bf16_t*)((char*)Olow + (unsigned)(lane_off + osgn * c0 * (DM * 2))) = (bf16_t)(w & 0xffffu);
                *(bf16_t*)((char*)Olow + (unsigned)(lane_off + osgn * (c0 + 1) * (DM * 2))) = (bf16_t)(w >> 16); }
    }
}

struct ChunkPtrs { const char *Kl, *Ql, *Vl, *Tp, *Gp; const float *GCp, *BEl; bool isx; };
__device__ __forceinline__ ChunkPtrs chunk_ptrs(int cidx, int dir, int b, int h, int sl, const bf16_t* KNx, const bf16_t* VNx, const bf16_t* KNc, const bf16_t* VNc, const bf16_t* QN, const float* BETA, const float* GC, const bf16_t* TT, const bf16_t* QG) {
    ChunkPtrs C; C.isx = cidx >= 4; const int cl = C.isx ? cidx - 4 : cidx, Ls = C.isx ? SEQL : CTXL;
    const int tlow = dir ? Ls - 64 - cl * 64 : cl * 64;
    C.Kl = (const char*)((C.isx ? KNx + (size_t)b * SEQL * DM : KNc + (size_t)b * CTXL * DM) + (size_t)tlow * DM + h * 128);
    C.Vl = (const char*)((C.isx ? VNx + (size_t)b * SEQL * DM : VNc + (size_t)b * CTXL * DM) + (size_t)tlow * DM + h * 128 + sl * 32);
    C.Ql = (const char*)(QN + ((size_t)b * SEQL + tlow) * DM + h * 128);
    const size_t item = (size_t)((dir * 4 + b) * 8 + h) * NCH + cidx;
    C.Tp = (const char*)(TT + item * 4096); C.Gp = (const char*)(QG + item * 4096); C.GCp = GC + item * 64;
    C.BEl = BETA + ((size_t)dir * MROWS + (C.isx ? b * SEQL : NTOK + b * CTXL) + tlow) * 8 + h;
    return C;
}
template <int NPW> struct PRegs { u32x4 buf[(52 + NPW - 1) / NPW]; float gc, gce, be; };
template <int NPW, int PW> __device__ __forceinline__ void prod_load(PRegs<NPW>& R, const ChunkPtrs& C, int dir, int lane) {
    constexpr int NS = (52 + NPW - 1) / NPW;
    asm volatile("" : "+v"(lane));
    if (PW == NPW - 1) { if (lane < 64) { R.gc = C.GCp[lane]; R.gce = C.GCp[63]; R.be = C.BEl[(dir ? 63 - lane : lane) * 8]; } }
#pragma unroll
    for (int m = 0; m < NS; ++m) { const int j = PW + NPW * m; R.buf[m] = (u32x4){0u, 0u, 0u, 0u};
        if (j < 16) { const int tr = dir ? 63 - lane : lane; R.buf[m] = *(const u32x4*)(C.Kl + (unsigned)(tr * (DM * 2) + 16 * j)); }
        else if (j < 32) { if (C.isx) { const int i = 4 * (j - 16) + (lane >> 4), tr = dir ? 63 - i : i; R.buf[m] = *(const u32x4*)(C.Ql + (unsigned)(tr * (DM * 2) + 16 * (lane & 15))); } }
        else if (j < 40) { if ((lane & 7) <= j - 32) R.buf[m] = *(const u32x4*)(C.Tp + (unsigned)((64 * (j - 32) + lane) * 16)); }
        else if (j < 48) { if (C.isx && (lane & 7) <= j - 40) R.buf[m] = *(const u32x4*)(C.Gp + (unsigned)((64 * (j - 40) + lane) * 16)); }
        else if (j < 52) { const int i = 16 * (j - 48) + (lane >> 2), tr = dir ? 63 - i : i; R.buf[m] = *(const u32x4*)(C.Vl + (unsigned)(tr * (DM * 2) + 16 * (lane & 3))); } }
}
template <int P16> __device__ __forceinline__ int colpos(int p8) { return P16 ? pos16lo(p8) : (16 * (p8 >> 1) + 4 * (p8 & 1)); }
template <int NPW, int PW, int P16> __device__ __forceinline__ void prod_write(const PRegs<NPW>& R, bool isx, unsigned char* st, int lane) {
    constexpr int NS = (52 + NPW - 1) / NPW;
    asm volatile("" : "+v"(lane));
    if (PW == NPW - 1) { if (lane < 64) { ((float*)(st + SC_BE))[lane] = R.be; ((float*)(st + SC_EG))[lane] = __expf(R.gc); ((float*)(st + SC_ED))[lane] = __expf(R.gce - R.gc); } }
#pragma unroll
    for (int m = 0; m < NS; ++m) { const int j = PW + NPW * m; const u32x2 lo = (u32x2){R.buf[m].x, R.buf[m].y}, hi = (u32x2){R.buf[m].z, R.buf[m].w};
        const unsigned w4[4] = {R.buf[m].x, R.buf[m].y, R.buf[m].z, R.buf[m].w};
        if (j < 16) { unsigned char* d = st + SC_K + lane * 272 + colpos<P16>(j) * 2; *(u32x2*)d = lo; *(u32x2*)(d + 16) = hi;
            unsigned char* t = st + SC_KT + (8 * j) * 144 + (P16 ? perm32(lane) : perm16(lane)) * 2;
#pragma unroll
            for (int e = 0; e < 4; ++e) { *(bf16_t*)(t + (2 * e) * 144) = (bf16_t)(w4[e] & 0xffffu); *(bf16_t*)(t + (2 * e + 1) * 144) = (bf16_t)(w4[e] >> 16); } }
        else if (j < 32) { if (isx) { unsigned char* d = st + SC_Q + (4 * (j - 16) + (lane >> 4)) * 272 + colpos<P16>(lane & 15) * 2; *(u32x2*)d = lo; *(u32x2*)(d + 16) = hi; } }
        else if (j < 40) { unsigned char* d = st + SC_T + (8 * (j - 32) + (lane >> 3)) * 144 + colpos<P16>(lane & 7) * 2; *(u32x2*)d = lo; *(u32x2*)(d + 16) = hi; }
        else if (j < 48) { if (isx) { unsigned char* d = st + SC_QG + (8 * (j - 40) + (lane >> 3)) * 144 + colpos<P16>(lane & 7) * 2; *(u32x2*)d = lo; *(u32x2*)(d + 16) = hi; } }
        else if (j < 52) { const int i = 16 * (j - 48) + (lane >> 2); unsigned char* d = st + SC_V + (((i >> 2) * 32 + 8 * (lane & 3)) * 4 + (i & 3)) * 2;
#pragma unroll
            for (int e = 0; e < 4; ++e) { *(bf16_t*)(d + 16 * e) = (bf16_t)(w4[e] & 0xffffu); *(bf16_t*)(d + 16 * e + 8) = (bf16_t)(w4[e] >> 16); } } }
}
template <int NPW, int PW, int P16> __device__ __forceinline__ void prod_run(unsigned char* shm, int dir, int b, int h, int sl, const bf16_t* KNx, const bf16_t* VNx, const bf16_t* KNc, const bf16_t* VNc, const bf16_t* QN,
                                                                             const float* BETA, const float* GC, const bf16_t* TT, const bf16_t* QG, int lane) {
#define CPT(c) chunk_ptrs((c), dir, b, h, sl, KNx, VNx, KNc, VNc, QN, BETA, GC, TT, QG)
    PRegs<NPW> RA, RB;
    prod_load<NPW, PW>(RA, CPT(0), dir, lane);
    prod_write<NPW, PW, P16>(RA, false, shm, lane);
    prod_load<NPW, PW>(RB, CPT(1), dir, lane);
    prod_load<NPW, PW>(RA, CPT(2), dir, lane);
    __syncthreads();
    for (int n = 0; n < NCH; n += 2) {
        prod_write<NPW, PW, P16>(RB, n + 1 >= 4, shm + SC_STAGE, lane);
        if (n + 3 < NCH) prod_load<NPW, PW>(RB, CPT(n + 3), dir, lane);
        __syncthreads();
        if (n + 2 < NCH) prod_write<NPW, PW, P16>(RA, n + 2 >= 4, shm, lane);
        if (n + 4 < NCH) prod_load<NPW, PW>(RA, CPT(n + 4), dir, lane);
        __syncthreads();
    }
#undef CPT
}

__device__ __forceinline__ void phase_scan_chunked(unsigned char* shm, const bf16_t* KNx, const bf16_t* VNx, const bf16_t* KNc, const bf16_t* VNc, const bf16_t* QN, const float* BETA, const float* GC,
                                                   const bf16_t* TT, const bf16_t* QG, bf16_t* OF, bf16_t* OB, int wave, int lane, int tid) {
    for (int it = blockIdx.x; it < 256; it += gridDim.x) {
        const int scan = (it >> 5) * 8 + (it & 7), sl = (it >> 3) & 3;
        const int dir = scan >> 5, b = (scan >> 3) & 3, h = scan & 7;
        bf16_t* Obase = (dir ? OB : OF) + (size_t)b * SEQL * DM + h * 128 + sl * 32;
        __syncthreads();
#if SCAN16
        if (wave < 2) {
            f32x4 S[8]; bf16x8 Sb[4];
#pragma unroll
            for (int t = 0; t < 8; ++t) S[t] = (f32x4){0.f, 0.f, 0.f, 0.f};
#pragma unroll
            for (int kb = 0; kb < 4; ++kb) Sb[kb] = (bf16x8){0, 0, 0, 0, 0, 0, 0, 0};
            __syncthreads();
            for (int n = 0; n < NCH; ++n) {
                const bool isx = n >= 4; const int cl = isx ? n - 4 : n;
                const int tlow = dir ? SEQL - 64 - cl * 64 : cl * 64;
                scan_consume16(shm + (n & 1) * SC_STAGE, S, Sb, isx, Obase + (size_t)tlow * DM, dir, wave, lane);
                asm volatile("" ::: "memory"); __builtin_amdgcn_s_barrier(); asm volatile("" ::: "memory");
            }
        } else {
#define PRUN(PW) prod_run<6, PW, 1>(shm, dir, b, h, sl, KNx, VNx, KNc, VNc, QN, BETA, GC, TT, QG, lane)
            switch (wave) { case 2: PRUN(0); break; case 3: PRUN(1); break; case 4: PRUN(2); break; case 5: PRUN(3); break; case 6: PRUN(4); break; default: PRUN(5); break; }
#undef PRUN
        }
#else
        if (wave == 0) {
            f32x16 S[4]; bf16x8 Sb[4][2];
#pragma unroll
            for (int kt = 0; kt < 4; ++kt) { S[kt] = zero16(); Sb[kt][0] = (bf16x8){0, 0, 0, 0, 0, 0, 0, 0}; Sb[kt][1] = (bf16x8){0, 0, 0, 0, 0, 0, 0, 0}; }
            __syncthreads();
            for (int n = 0; n < NCH; ++n) {
                const bool isx = n >= 4; const int cl = isx ? n - 4 : n;
                const int tlow = dir ? SEQL - 64 - cl * 64 : cl * 64;
                scan_consume(shm + (n & 1) * SC_STAGE, S, Sb, isx, Obase + (size_t)tlow * DM, dir, lane);
                __syncthreads();
            }
        } else {
#define PRUN(PW) prod_run<7, PW, 0>(shm, dir, b, h, sl, KNx, VNx, KNc, VNc, QN, BETA, GC, TT, QG, lane)
            switch (wave) { case 1: PRUN(0); break; case 2: PRUN(1); break; case 3: PRUN(2); break; case 4: PRUN(3); break; case 5: PRUN(4); break; case 6: PRUN(5); break; default: PRUN(6); break; }
#undef PRUN
        }
#endif
    }
}

__device__ __forceinline__ void phase_ogate(const Args& a, bf16_t* OF, const bf16_t* OB, const bf16_t* ZS, int gw, int NGW, int lane) {
    const float* og = a.in[11];
    for (int r0 = gw; r0 < NTOK; r0 += 2 * NGW) {
        const int r1 = r0 + NGW; const bool has1 = r1 < NTOK; const int rr[2] = {r0, has1 ? r1 : r0};
        u32x4 L[2][6];
#pragma unroll
        for (int u = 0; u < 2; ++u) { const size_t off = (size_t)rr[u] * DM + lane * 16;
            L[u][0] = *(const u32x4*)(OF + off); L[u][1] = *(const u32x4*)(OF + off + 8); L[u][2] = *(const u32x4*)(OB + off); L[u][3] = *(const u32x4*)(OB + off + 8); L[u][4] = *(const u32x4*)(ZS + off); L[u][5] = *(const u32x4*)(ZS + off + 8); }
#pragma unroll
        for (int u = 0; u < 2; ++u) { if (u == 1 && !has1) break;
            const size_t off = (size_t)rr[u] * DM + lane * 16;
            const unsigned fu[8] = {L[u][0].x, L[u][0].y, L[u][0].z, L[u][0].w, L[u][1].x, L[u][1].y, L[u][1].z, L[u][1].w}, bu[8] = {L[u][2].x, L[u][2].y, L[u][2].z, L[u][2].w, L[u][3].x, L[u][3].y, L[u][3].z, L[u][3].w},
                           zu[8] = {L[u][4].x, L[u][4].y, L[u][4].z, L[u][4].w, L[u][5].x, L[u][5].y, L[u][5].z, L[u][5].w};
            float o[16]; float ss = 0.f;
#pragma unroll
            for (int e = 0; e < 8; ++e) { o[2 * e] = bflo(fu[e]) + bflo(bu[e]); o[2 * e + 1] = bfhi(fu[e]) + bfhi(bu[e]); ss += o[2 * e] * o[2 * e] + o[2 * e + 1] * o[2 * e + 1]; }
            ss += __shfl_xor(ss, 1); ss += __shfl_xor(ss, 2); ss += __shfl_xor(ss, 4);
            const float rs = 1.0f / sqrtf(ss * (1.0f / HD) + EPS);
            const float* gp = og + (lane & 7) * 16;
            unsigned w[8];
#pragma unroll
            for (int e = 0; e < 8; ++e) w[e] = pk2(o[2 * e] * rs * gp[2 * e] * bflo(zu[e]), o[2 * e + 1] * rs * gp[2 * e + 1] * bfhi(zu[e]));
            *(u32x4*)(OF + off) = (u32x4){w[0], w[1], w[2], w[3]}; *(u32x4*)(OF + off + 8) = (u32x4){w[4], w[5], w[6], w[7]}; }
    }
}

__device__ __forceinline__ void phase_final(float* X, const float* g, int gw, int NGW, int lane) {
    for (int r = gw; r < NTOK; r += NGW) {
        float* src = X + (size_t)r * DM;
        f32x4 v[4]; float ss = 0.f;
#pragma unroll
        for (int j = 0; j < 4; ++j) { v[j] = *(const f32x4*)(src + 4 * lane + 256 * j); ss += (v[j][0] * v[j][0] + v[j][1] * v[j][1]) + (v[j][2] * v[j][2] + v[j][3] * v[j][3]); }
        ss = wave_sum(ss);
        const float rs = 1.0f / sqrtf(ss * (1.0f / DM) + EPS);
#pragma unroll
        for (int j = 0; j < 4; ++j) { const f32x4 gg = *(const f32x4*)(g + 4 * lane + 256 * j); *(f32x4*)(src + 4 * lane + 256 * j) = v[j] * rs * gg; }
    }
}

#define LAS __attribute__((address_space(3)))
#define XB_TMO      128
#define XB_XCNT(j)  (256  + 64 * (j))
#define XB_XSUB(j)  (1280 + 64 * (j))
#define XB_XGEN(j)  (2304 + 64 * (j))
#define XB_TOP      3328
#define XB_TOPGEN   3392
#define XCD_BAR_WORDS 3456
#define XB_SPIN_CAP (1u << 18)

__device__ __forceinline__ unsigned xb_ld(unsigned* p)              { return __hip_atomic_load(p, __ATOMIC_RELAXED, __HIP_MEMORY_SCOPE_AGENT); }
__device__ __forceinline__ unsigned xb_add(unsigned* p, unsigned v) { return __hip_atomic_fetch_add(p, v, __ATOMIC_RELAXED, __HIP_MEMORY_SCOPE_AGENT); }
__device__ __forceinline__ unsigned xb_xcc_id() { return (unsigned)__builtin_amdgcn_s_getreg((3 << 11) | 20) & 0xFu; }
#define XB_SPIN(cond, bar) do { unsigned _sp = 0; while (cond) { __builtin_amdgcn_s_sleep(1); \
    if ((++_sp & 255u) == 0u) { if (xb_ld(&(bar)[XB_TMO])) break; if (_sp > XB_SPIN_CAP) { atomicAdd(&(bar)[XB_TMO], 1u); break; } } } } while (0)

struct XcdBarrier {
    unsigned* bar; unsigned x;
    volatile LAS unsigned* st;
};

__device__ __forceinline__ XcdBarrier xcd_barrier_post(unsigned* bar, volatile LAS unsigned* st) {
    XcdBarrier b; b.bar = bar; b.x = xb_xcc_id(); b.st = st;
    if (threadIdx.x == 0) (void)xb_add(&bar[XB_XCNT(b.x)], 1u);
    return b;
}
__device__ __forceinline__ void xcd_barrier_complete(unsigned* bar, unsigned x, unsigned& nloc, unsigned& nx) {
    const unsigned G = gridDim.x * gridDim.y * gridDim.z;
    unsigned sum, cnt, mine, sp = 0u;
    for (;;) {
        sum = 0u; cnt = 0u; mine = 0u;
#pragma unroll
        for (unsigned j = 0; j < 16; ++j) { const unsigned c = xb_ld(&bar[XB_XCNT(j)]); sum += c; cnt += (c > 0u) ? 1u : 0u; mine = (j == x) ? c : mine; }
        if (sum == G) break;
        __builtin_amdgcn_s_sleep(1);
        if ((++sp & 255u) == 0u) { if (xb_ld(&bar[XB_TMO])) break; if (sp > XB_SPIN_CAP) { atomicAdd(&bar[XB_TMO], 1u); break; } }
    }
    nloc = mine > 0u ? mine : 1u; nx = cnt > 0u ? cnt : 1u;
}

__device__ __forceinline__ void xcd_barrier(const XcdBarrier& b) {
    asm volatile("s_waitcnt vmcnt(0)" ::: "memory");
    __syncthreads();
    if (threadIdx.x == 0) {
        unsigned* bar = b.bar;
        __builtin_amdgcn_s_waitcnt(0);
        unsigned nloc = b.st[0], nx = b.st[1];
        if (nloc == 0u) { xcd_barrier_complete(bar, b.x, nloc, nx); b.st[0] = nloc; b.st[1] = nx; }
        const unsigned old = xb_add(&bar[XB_XSUB(b.x)], 1u);
        const unsigned gen = old / nloc;
        if (old + 1u == (gen + 1u) * nloc) {
            __builtin_amdgcn_fence(__ATOMIC_RELEASE, "agent");
            asm volatile("s_waitcnt vmcnt(0)" ::: "memory");
            const unsigned og = xb_add(&bar[XB_TOP], 1u);
            const unsigned tg = og / nx;
            if (og + 1u == (tg + 1u) * nx) xb_add(&bar[XB_TOPGEN], 1u);
            else XB_SPIN(xb_ld(&bar[XB_TOPGEN]) == tg, bar);
            __builtin_amdgcn_fence(__ATOMIC_ACQUIRE, "agent");
            xb_add(&bar[XB_XGEN(b.x)], 1u);
            asm volatile("s_waitcnt vmcnt(0)" ::: "memory");
        } else {
            XB_SPIN(xb_ld(&bar[XB_XGEN(b.x)]) == gen, bar);
            __builtin_amdgcn_fence(__ATOMIC_ACQUIRE, "agent");
            asm volatile("s_waitcnt vmcnt(0)" ::: "memory");
        }
    }
    __syncthreads();
}


__global__ void __launch_bounds__(512, 2) mk_fwd(Args a) {
    extern __shared__ __attribute__((aligned(16))) unsigned char shm[];
    const int tid = threadIdx.x, lane = tid & 63, wave = __builtin_amdgcn_readfirstlane(tid >> 6);
    const int G = gridDim.x, gw = blockIdx.x * 8 + wave, NGW = G * 8;
    unsigned char* ws = a.ws;
    PG8_LAS unsigned char* lds = (PG8_LAS unsigned char*)shm;
    const int lo = a.ph_lo, hi = a.ph_hi;
    float* MOD = (float*)(ws + WS_MOD);
    bf16_t* UG = (bf16_t*)a.out; bf16_t* VG = UG + (size_t)NTOK * DM;
    bf16_t* KNx = (bf16_t*)a.out; bf16_t* VNx = KNx + (size_t)NTOK * DM;
#define IN(k) (lo <= (k) && (k) < hi)
#ifndef REP_K
#define REP_K -1
#endif
#define REPS(k) for (int rp_ = 0; rp_ < ((k) == REP_K ? 2 : 1); ++rp_)
    volatile LAS unsigned* bst = (volatile LAS unsigned*)(lds + (LDS_BYTES - 16));
    if (tid < 4) bst[tid] = 0u;
    __syncthreads();
    XcdBarrier xbar; xbar.bar = (unsigned*)(ws + WS_CTL); xbar.x = 0; xbar.st = bst;
    if (a.coop) xbar = xcd_barrier_post((unsigned*)(ws + WS_CTL), bst);
#define SEAM(k) do { if (IN(k) && IN((k) + 1)) { if (a.coop == 2) cg::this_grid().sync(); else if (a.coop) xcd_barrier(xbar); } } while (0)

    const bool fuse_norm = (a.coop != 0) && (G == 256);
    bf16_t* OFp = (bf16_t*)(ws + WS_OF); bf16_t* OBp = (bf16_t*)(ws + WS_OB);
    if (IN(0)) REPS(0) { phase0(a, shm, gw, NGW, wave, lane, tid); } SEAM(0);
    if (IN(1)) REPS(1) { norm_mod_rows(a.in[0], NTOK, a.in[2], NCTX, a.in[6], MOD, 0, 1024, (bf16_t*)(ws + WS_A1), gw, NGW, lane); } SEAM(1);
#ifdef DUP_GEMM2
    if (IN(2)) {
        pg8::Gemm g{(const bf16_t*)(ws + WS_A1), (const bf16_t*)(ws + WS_W1T), MROWS, 3328, DM};
        Order1a S{G, (int)blockIdx.x};
        EpiSel E{(bf16_t*)(ws + WS_R1), (bf16_t*)(ws + WS_R1) + 1024, (bf16_t*)(ws + WS_QRAW), nullptr, nullptr, 2048, 2048, 1024, 0, 0, 0, 0, 0, 0, 0, 12, (float*)(ws + WS_BA)};
        pg8::gemm_phase<EpiSel, Order1a, false>(lds, g, S, E, nullptr);
    }
#endif
    if (IN(2)) {
        pg8::Gemm g{(const bf16_t*)(ws + WS_A1), (const bf16_t*)(ws + WS_W1T), MROWS, 3328, DM};
        Order1a S{G, (int)blockIdx.x};
        EpiSel E{(bf16_t*)(ws + WS_R1), (bf16_t*)(ws + WS_R1) + 1024, (bf16_t*)(ws + WS_QRAW), nullptr, nullptr, 2048, 2048, 1024, 0, 0, 0, 0, 0, 0, 0, 12, (float*)(ws + WS_BA)};
        pg8::gemm_phase<EpiSel, Order1a, false>(lds, g, S, E, nullptr);
    } SEAM(2);
    if (IN(3)) REPS(3) { phase_conv_prep(a, (const bf16_t*)(ws + WS_R1), (const bf16_t*)(ws + WS_QRAW), (const float*)(ws + WS_BA), KNx, VNx, (bf16_t*)(ws + WS_KNC), (bf16_t*)(ws + WS_VNC), (bf16_t*)(ws + WS_QN),
                                 (float*)(ws + WS_BETA), (float*)(ws + WS_G), gw, NGW, lane); } SEAM(3);
    if (IN(4)) REPS(4) {
#if USE_CHUNKED
        phase_chunk_prep(shm, KNx, (const bf16_t*)(ws + WS_KNC), (const bf16_t*)(ws + WS_QN), (const float*)(ws + WS_BETA), (const float*)(ws + WS_G),
                         (bf16_t*)(ws + WS_TT), (bf16_t*)(ws + WS_QG), (float*)(ws + WS_GC), gw, NGW, wave, lane);
#endif
    } SEAM(4);
    if (IN(5)) REPS(5) {
#if USE_CHUNKED
        phase_scan_chunked(shm, KNx, VNx, (const bf16_t*)(ws + WS_KNC), (const bf16_t*)(ws + WS_VNC), (const bf16_t*)(ws + WS_QN), (const float*)(ws + WS_BETA), (const float*)(ws + WS_GC),
                           (const bf16_t*)(ws + WS_TT), (const bf16_t*)(ws + WS_QG), OFp, OBp, wave, lane, tid);
#else
        phase_scan(KNx, VNx, (const bf16_t*)(ws + WS_KNC), (const bf16_t*)(ws + WS_VNC), (const bf16_t*)(ws + WS_QN), (const float*)(ws + WS_BETA), (const float*)(ws + WS_G), OFp, OBp, gw, NGW, lane);
#endif
    } SEAM(5);
#ifdef DUP_GEMM6
    if (IN(6)) {
        pg8::Gemm g{(const bf16_t*)(ws + WS_A1), (const bf16_t*)(ws + WS_W1T) + (size_t)3328 * DM, NTOK, 5120, DM};
        pg8::StaticOrder S; S.init(NTOK, 5120, G, (int)blockIdx.x);
        EpiSel E{UG, VG, (bf16_t*)(ws + WS_ZS), (bf16_t*)(ws + WS_GA), (bf16_t*)(ws + WS_GB), 1024, 1024, 1024, 1024, 1024, 1, 1, 2, 3, 3, -1, nullptr};
        pg8::gemm_phase<EpiSel, pg8::StaticOrder, false>(lds, g, S, E, nullptr);
    }
#endif
    if (IN(6)) {
        pg8::Gemm g{(const bf16_t*)(ws + WS_A1), (const bf16_t*)(ws + WS_W1T) + (size_t)3328 * DM, NTOK, 5120, DM};
        pg8::StaticOrder S; S.init(NTOK, 5120, G, (int)blockIdx.x);
        EpiSel E{UG, VG, (bf16_t*)(ws + WS_ZS), (bf16_t*)(ws + WS_GA), (bf16_t*)(ws + WS_GB), 1024, 1024, 1024, 1024, 1024, 1, 1, 2, 3, 3, -1, nullptr};
        pg8::gemm_phase<EpiSel, pg8::StaticOrder, false>(lds, g, S, E, nullptr);
    } SEAM(6);
    if (IN(7)) { phase_ogate(a, OFp, OBp, (const bf16_t*)(ws + WS_ZS), gw, NGW, lane); }
    if (IN(8)) REPS(8) { phase_branch_a(a, shm, UG, VG, (bf16_t*)(ws + WS_AA), wave, lane, tid); } SEAM(8);
#ifdef DUP_GEMM9
    if (IN(9)) {
        pg8::Gemm g{(const bf16_t*)(ws + WS_AA), (const bf16_t*)(ws + WS_WAT), NTOK, DM, DM};
        pg8::StaticOrder S; S.init(NTOK, DM, G, (int)blockIdx.x);
        EpiGate E{(const bf16_t*)(ws + WS_GA), nullptr, (bf16_t*)(ws + WS_T1)};
        pg8::gemm_phase<EpiGate, pg8::StaticOrder, false>(lds, g, S, E, nullptr);
    }
#endif
    static_assert(WS_OF - WS_AA == (size_t)204 * 256 * DM * 2 && WS_WBT - WS_WAT == (size_t)4 * 256 * DM * 2, "OrderAB aliasing");
    if (IN(9) && IN(10)) {
        pg8::Gemm g{(const bf16_t*)(ws + WS_AA), (const bf16_t*)(ws + WS_WAT), NTOK, DM, DM};
        OrderAB S; S.S0.init(NTOK, DM, G, (int)blockIdx.x);
        EpiGateAB E{(const bf16_t*)(ws + WS_GA), (const bf16_t*)(ws + WS_GB), (bf16_t*)(ws + WS_MG)};
        pg8::gemm_phase<EpiGateAB, OrderAB, false>(lds, g, S, E, nullptr);
    } else {
    if (IN(9)) {
        pg8::Gemm g{(const bf16_t*)(ws + WS_AA), (const bf16_t*)(ws + WS_WAT), NTOK, DM, DM};
        pg8::StaticOrder S; S.init(NTOK, DM, G, (int)blockIdx.x);
        EpiGate E{(const bf16_t*)(ws + WS_GA), nullptr, (bf16_t*)(ws + WS_T1)};
        pg8::gemm_phase<EpiGate, pg8::StaticOrder, false>(lds, g, S, E, nullptr);
    }
    if (IN(10)) {
        pg8::Gemm g{(const bf16_t*)(ws + WS_OF), (const bf16_t*)(ws + WS_WBT), NTOK, DM, DM};
        pg8::StaticOrder S; S.init(NTOK, DM, G, (int)blockIdx.x);
        EpiGate E{(const bf16_t*)(ws + WS_GB), (const bf16_t*)(ws + WS_T1), (bf16_t*)(ws + WS_MG)};
        pg8::gemm_phase<EpiGate, pg8::StaticOrder, false>(lds, g, S, E, nullptr);
    }
    } SEAM(10);
    if (IN(11)) {
        pg8::Gemm g{(const bf16_t*)(ws + WS_MG), (const bf16_t*)(ws + WS_WOT), NTOK, DM, DM};
        pg8::StaticOrder S; S.init(NTOK, DM, G, (int)blockIdx.x);
        if (fuse_norm) {
            EpiResNorm<1> E{a.in[0], a.out, MOD + 2048, a.in[19], MOD, 3072, 4096, (bf16_t*)(ws + WS_A1), (float*)(ws + WS_XB), (unsigned*)(ws + WS_CTL + 16384)};
            pg8::gemm_phase<EpiResNorm<1>, pg8::StaticOrder, false>(lds, g, S, E, nullptr);
        } else {
            EpiRes E{a.in[0], a.out, MOD + 2048};
            pg8::gemm_phase<EpiRes, pg8::StaticOrder, false>(lds, g, S, E, nullptr);
        }
    } SEAM(11);
    if (IN(12) && !fuse_norm) { norm_mod_rows(a.out, NTOK, nullptr, 0, a.in[19], MOD, 3072, 4096, (bf16_t*)(ws + WS_A1), gw, NGW, lane); }
    if (!fuse_norm) SEAM(12);
#ifdef DUP_GEMM13
    if (IN(13)) {
        pg8::Gemm g{(const bf16_t*)(ws + WS_A1), (const bf16_t*)(ws + WS_WUPT), NTOK, 2 * DFF, DM};
        pg8::StaticOrder S; S.init(NTOK, 2 * DFF, G, (int)blockIdx.x);
        EpiUp E{a.in[21], a.in[22], (bf16_t*)(ws + WS_R1)};
        pg8::gemm_phase<EpiUp, pg8::StaticOrder, false>(lds, g, S, E, nullptr);
    }
#endif
    if (IN(13)) {
        pg8::Gemm g{(const bf16_t*)(ws + WS_A1), (const bf16_t*)(ws + WS_WUPT), NTOK, 2 * DFF, DM};
        pg8::StaticOrder S; S.init(NTOK, 2 * DFF, G, (int)blockIdx.x);
        EpiUp E{a.in[21], a.in[22], (bf16_t*)(ws + WS_R1)};
        pg8::gemm_phase<EpiUp, pg8::StaticOrder, false>(lds, g, S, E, nullptr);
    } SEAM(13);
    if (IN(14)) {
        pg8::Gemm g{(const bf16_t*)(ws + WS_R1), (const bf16_t*)(ws + WS_WDT), NTOK, DM, DFF};
        pg8::StaticOrder S; S.init(NTOK, DM, G, (int)blockIdx.x);
        if (fuse_norm) {
            EpiResNorm<0> E{a.out, a.out, MOD + 5120, a.in[24], nullptr, 0, 0, nullptr, (float*)(ws + WS_XB), (unsigned*)(ws + WS_CTL + 32768)};
            pg8::gemm_phase<EpiResNorm<0>, pg8::StaticOrder, false>(lds, g, S, E, nullptr);
        } else {
            EpiRes E{a.out, a.out, MOD + 5120};
            pg8::gemm_phase<EpiRes, pg8::StaticOrder, false>(lds, g, S, E, nullptr);
        }
    }
    if (!fuse_norm) SEAM(14);
    if (IN(15) && !fuse_norm) { phase_final(a.out, a.in[24], gw, NGW, lane); }
#ifdef EXTRA_SYNCS
    if (a.coop) for (int q_ = 0; q_ < EXTRA_SYNCS; ++q_) xcd_barrier(xbar);
#endif
#undef IN
#undef SEAM
}

#ifndef MK_PER_PHASE
#define MK_PER_PHASE 0
#endif

extern "C" void kernel_launch(void* const* d_in, const int* in_sizes, int n_in, void* d_out, int out_size, void* d_ws, size_t ws_size, hipStream_t stream) {
    static int grid = 0;
    if (grid == 0) {
        if (n_in != 25 || out_size != NTOK * DM || ws_size < WS_END) { fprintf(stderr, "kernel_launch: unexpected shapes (n_in %d out %d ws %zu)\n", n_in, out_size, ws_size); grid = -1; return; }
        int dev = 0, cus = 0, per_cu = 0;
        if (hipGetDevice(&dev) != hipSuccess || hipDeviceGetAttribute(&cus, hipDeviceAttributeMultiprocessorCount, dev) != hipSuccess) { grid = -1; return; }
        if (hipFuncSetAttribute((const void*)mk_fwd, hipFuncAttributeMaxDynamicSharedMemorySize, LDS_BYTES) != hipSuccess) { fprintf(stderr, "kernel_launch: hipFuncSetAttribute failed\n"); grid = -1; return; }
        if (hipOccupancyMaxActiveBlocksPerMultiprocessor(&per_cu, (const void*)mk_fwd, 512, LDS_BYTES) != hipSuccess || per_cu < 1) { fprintf(stderr, "kernel_launch: occupancy query says %d\n", per_cu); per_cu = 1; }
        (void)hipGetLastError();
        grid = cus;
    }
    if (grid < 0) return;
    Args a{};
    for (int i = 0; i < 25; ++i) a.in[i] = (const float*)d_in[i];
    a.out = (float*)d_out; a.ws = (unsigned char*)d_ws;
#if MK_PER_PHASE
    for (int p = 0; p < NPHASE; ++p) { a.ph_lo = p; a.ph_hi = p + 1; a.coop = 0;
        hipLaunchKernelGGL(mk_fwd, dim3(grid), dim3(512), LDS_BYTES, stream, a); }
#else
    if (hipMemsetAsync((char*)d_ws + WS_CTL, 0, 65536, stream) != hipSuccess) { fprintf(stderr, "kernel_launch: memset failed\n"); return; }
    a.ph_lo = 0; a.ph_hi = NPHASE; a.coop = 1;
    void* args[] = {&a};
    hipError_t e = hipLaunchCooperativeKernel((const void*)mk_fwd, dim3(grid), dim3(512), args, LDS_BYTES, stream);
    if (e != hipSuccess) fprintf(stderr, "cooperative launch failed: %s (grid %d)\n", hipGetErrorString(e), grid);
#endif
}
```
